# Optimizing an MI355X kernel written in HIP

```python
import jax, jax.numpy as jnp
from jax import lax
import numpy as np

D_MODEL = 1024
BATCH = 16
SEQ = 2048
DEPTH = 1

CHUNK = 64
SC_W = D_MODEL
SC_K = 3
RG_W = 1280
RG_HEADS = 16
RG_HEAD_DIM = RG_W // RG_HEADS
RG_K = 4
LRU_C = 8.0
EPS = 1e-6
P_IN = 4 * SC_W + 2 * RG_W + 2 * D_MODEL

kernel_name = "hybrid_shortconv_rglru_gated_merge_block"


def _rmsnorm(x, g):
    xf = x.astype(jnp.float32)
    y = xf * lax.rsqrt(jnp.mean(xf * xf, axis=-1, keepdims=True) + EPS)
    return (y * g.astype(jnp.float32)).astype(x.dtype)


def _causal_dwconv(u, w, b):
    k_taps = w.shape[0]
    s = u.shape[1]
    up = jnp.pad(u, ((0, 0), (k_taps - 1, 0), (0, 0)))
    y = b + up[:, 0:s] * w[0]
    for k in range(1, k_taps):
        y = y + up[:, k:k + s] * w[k]
    return y


def _lin_combine(e1, e2):
    a1, b1 = e1
    a2, b2 = e2
    return a1 * a2, a2 * b1 + b2


def _rg_lru(v, w_a, b_a, w_x, b_x, lam):
    bn, s, w = v.shape
    vh = v.reshape(bn, s, RG_HEADS, RG_HEAD_DIM)
    r = jax.nn.sigmoid(jnp.einsum('bshd,hde->bshe', vh, w_a).reshape(bn, s, w) + b_a)
    i = jax.nn.sigmoid(jnp.einsum('bshd,hde->bshe', vh, w_x).reshape(bn, s, w) + b_x)
    log_a = -LRU_C * r.astype(jnp.float32) * jax.nn.softplus(-lam.astype(jnp.float32))
    a = jnp.exp(log_a)
    bterm = jnp.sqrt(-jnp.expm1(2.0 * log_a)) * (i * v).astype(jnp.float32)
    nc = s // CHUNK
    a = a.reshape(bn, nc, CHUNK, w)
    bterm = bterm.reshape(bn, nc, CHUNK, w)
    cum_a, h_loc = lax.associative_scan(_lin_combine, (a, bterm), axis=2)

    def step(h, inp):
        ca, hl = inp
        hc = hl + ca * h[:, None, :]
        return hc[:, -1], hc

    h0 = jnp.zeros((bn, w), jnp.float32)
    _, hs = lax.scan(step, h0, (cum_a.transpose(1, 0, 2, 3), h_loc.transpose(1, 0, 2, 3)))
    return hs.transpose(1, 0, 2, 3).reshape(bn, s, w).astype(v.dtype)


def setup_inputs(seed: int = 0) -> dict:
    key = jax.random.key(seed)
    ks = jax.random.split(key, 24)
    f32 = jnp.float32
    L, D = DEPTH, D_MODEL
    nrm = lambda k, shp, sc: jax.random.normal(k, shp, f32) * sc
    u = jax.random.uniform(ks[15], (L, RG_W), f32, 0.9, 0.999)
    s_l = u ** (1.0 / LRU_C)
    rg_lambda = jnp.log(s_l) - jnp.log1p(-s_l)
    return {
        "x": nrm(ks[0], (BATCH, SEQ, D), 1.0),
        "c": nrm(ks[1], (BATCH, D), 1.0),
        "w_ada": nrm(ks[2], (L, D, 3 * D), 0.5 * D ** -0.5),
        "b_ada": nrm(ks[3], (L, 3 * D), 0.02),
        "g_norm": 1.0 + nrm(ks[4], (L, D), 0.02),
        "w_in": nrm(ks[5], (L, D, P_IN), D ** -0.5),
        "sc_conv_w": nrm(ks[6], (L, SC_K, SC_W), SC_K ** -0.5),
        "sc_conv_b": nrm(ks[7], (L, SC_W), 0.02),
        "sc_w_out": nrm(ks[8], (L, SC_W, D), SC_W ** -0.5),
        "rg_conv_w": nrm(ks[9], (L, RG_K, RG_W), RG_K ** -0.5),
        "rg_conv_b": nrm(ks[10], (L, RG_W), 0.02),
        "rg_w_a": nrm(ks[11], (L, RG_HEADS, RG_HEAD_DIM, RG_HEAD_DIM), RG_HEAD_DIM ** -0.5),
        "rg_b_a": nrm(ks[12], (L, RG_W), 0.02),
        "rg_w_x": nrm(ks[13], (L, RG_HEADS, RG_HEAD_DIM, RG_HEAD_DIM), RG_HEAD_DIM ** -0.5),
        "rg_b_x": nrm(ks[14], (L, RG_W), 0.02),
        "rg_lambda": rg_lambda,
        "rg_w_out": nrm(ks[16], (L, RG_W, D), RG_W ** -0.5),
        "b_merge": nrm(ks[17], (L, 2, D), 0.02),
        "w_out": nrm(ks[18], (L, D, D), D ** -0.5),
        "g_final": 1.0 + nrm(ks[19], (D,), 0.02),
    }


def reference(x, c, w_ada, b_ada, g_norm, w_in, sc_conv_w, sc_conv_b, sc_w_out,
              rg_conv_w, rg_conv_b, rg_w_a, rg_b_a, rg_w_x, rg_b_x, rg_lambda,
              rg_w_out, b_merge, w_out, g_final):
    sizes = [SC_W] * 4 + [RG_W] * 2 + [D_MODEL] * 2
    split_idx = [int(v) for v in np.cumsum(sizes)[:-1]]
    c_act = jax.nn.silu(c)
    for l in range(DEPTH):
        mod = c_act @ w_ada[l] + b_ada[l]
        shift, scale, gate = jnp.split(mod, 3, axis=-1)
        h = _rmsnorm(x, g_norm[l]) * (1.0 + scale[:, None, :]) + shift[:, None, :]
        z = h @ w_in[l]
        sc_b, sc_c, sc_v, sc_g, rg_v, rg_g, m_a, m_b = jnp.split(z, split_idx, axis=-1)
        u = _causal_dwconv(sc_c * sc_v, sc_conv_w[l], sc_conv_b[l])
        y_a = (sc_b * u * jax.nn.silu(sc_g)) @ sc_w_out[l]
        v = _causal_dwconv(rg_v, rg_conv_w[l], rg_conv_b[l])
        y_rg = _rg_lru(v, rg_w_a[l], rg_b_a[l], rg_w_x[l], rg_b_x[l], rg_lambda[l])
        y_b = (y_rg * jax.nn.silu(rg_g)) @ rg_w_out[l]
        g_a = jax.nn.sigmoid(m_a + b_merge[l, 0])
        g_b = jax.nn.sigmoid(m_b + b_merge[l, 1])
        merged = g_a * y_a + g_b * y_b
        x = x + gate[:, None, :] * (merged @ w_out[l])
    return _rmsnorm(x, g_final)
```

```cpp
#include <hip/hip_runtime.h>
#include <hip/hip_cooperative_groups.h>
#include <cstdio>
#include <cstdint>
namespace cg = cooperative_groups;

#ifndef N_LAUNCHES
#define N_LAUNCHES 1
#endif

namespace pg8 {
#define PG8_LAS __attribute__((address_space(3)))
typedef unsigned short bf16_t;
typedef short bf16x8 __attribute__((ext_vector_type(8)));
typedef float f32x4 __attribute__((ext_vector_type(4)));
typedef unsigned u32x4 __attribute__((ext_vector_type(4)));
constexpr int BM = 256, BK = 64, HALF = 128, HTB = HALF * BK * 2  , STAGE_BYTES = 8 * HTB, NXCD = 8, WGM = 8;

__host__ __device__ __forceinline__ int lds_byte(int r, int c) { const int st = (r >> 4) * 2 + (c >> 5), rr = r & 15, cc = c & 31, ob = rr * 64 + cc * 2; return st * 1024 + (ob ^ (((ob >> 9) & 1) << 5)); }
__host__ __device__ __forceinline__ void stage_rc(int b, int& R, int& C) { const int st = b / 1024, sb = b % 1024, swz = sb ^ (((sb >> 9) & 1) << 5); R = (st >> 1) * 16 + swz / 64; C = (st & 1) * 32 + (swz % 64) / 2; }
__host__ __device__ __forceinline__ int perm32(int rho) { const int n = rho >> 4, i = rho & 15; return 8 * (i >> 2) + 4 * n + (i & 3); }

struct Unit { int pm, pn; };
struct Gemm { const bf16_t* A; const bf16_t* Bt; int M, N, K, lda, ldb; };

struct StaticOrder {
    int nM, nN, nwg, G, c;
    __host__ __device__ void init(int M, int N, int G_, int c_) { nM = M / BM; nN = N / BM; nwg = nM * nN; G = G_; c = c_; }
    __host__ __device__ bool next(int i, Unit& u) const {
        const long L = (long)i * G + c; if (L >= nwg) return false;
        int wgid = (int)L; { const int q = nwg / NXCD, r = nwg % NXCD, xcd = wgid % NXCD, off = wgid / NXCD; wgid = (xcd < r ? xcd * (q + 1) : r * (q + 1) + (xcd - r) * q) + off; }
        const int nig = WGM * nN, gid = wgid / nig, fm = gid * WGM, gsz = (nM - fm) < WGM ? (nM - fm) : WGM;
        u.pm = fm + ((wgid % nig) % gsz); u.pn = (wgid % nig) / gsz; return true;
    }
    __device__ __forceinline__ void a_ready(const Unit&) const {}
    __device__ __forceinline__ void done(const Unit&) const {}
};
typedef __bf16 bf16x2_t __attribute__((ext_vector_type(2)));
typedef float f32x2_t __attribute__((ext_vector_type(2)));
__device__ __forceinline__ unsigned cvt_pk_bf16(float lo, float hi) { const f32x2_t v = {lo, hi}; const bf16x2_t b = __builtin_convertvector(v, bf16x2_t); return __builtin_bit_cast(unsigned, b); }

template <class Epi, class Sched, bool ALIGN_EPI = false, bool SP2 = false>
__device__ __forceinline__ void gemm_phase(PG8_LAS unsigned char* lds, const Gemm g, const Sched& S, const Epi& E) {
    const int tid = threadIdx.x, wid = __builtin_amdgcn_readfirstlane(tid >> 6), lane = tid & 63, wr = wid >> 2, wc = wid & 3, fr = lane & 15, fq = lane >> 4;
    const int K = g.K, nt = K / BK;
    unsigned voffA[2], voffB[2];
#pragma unroll
    for (int i = 0; i < 2; ++i) { int R, C; stage_rc(tid * 16 + i * 8192, R, C); const int Rb = Epi::PERM ? ((R & ~31) + perm32(R & 31)) : R;
        voffA[i] = (unsigned)(R * g.lda + C) * 2u; voffB[i] = (unsigned)(Rb * g.ldb + C) * 2u; }
    const size_t kstep = (size_t)(BK * 2);
    const size_t hstepA = (size_t)HALF * g.lda * 2, hstepB = (size_t)HALF * g.ldb * 2;
    const size_t tstepA = 2 * hstepA, tstepB = 2 * hstepB;
    const unsigned ldsw = (unsigned)wid * 1024u;
    const int aoff = lds_byte(wr * 64 + fr, fq * 8), boff = lds_byte(wc * 32 + fr, fq * 8);
#define PG8_SA(b, h) (((b) * 2 + (h)) * HTB)
#define PG8_SB(b, h) ((4 + (b) * 2 + (h)) * HTB)
#define PG8_STAGE(bufoff, gbase, voff) do { _Pragma("unroll") for (int _i = 0; _i < 2; ++_i) \
        __builtin_amdgcn_global_load_lds((const unsigned*)((const char*)(gbase) + (voff)[_i]), (PG8_LAS unsigned*)(lds + (bufoff) + ldsw + _i * 8192), 16, 0, 0); } while (0)
#define PG8_LDA(dst, b, h) do { _Pragma("unroll") for (int m = 0; m < 4; ++m) _Pragma("unroll") for (int k = 0; k < 2; ++k) dst[m][k] = *(const PG8_LAS bf16x8*)(lds + PG8_SA(b, h) + aoff + m * 2048 + k * 1024); } while (0)
#define PG8_LDB(dst, b, h) do { _Pragma("unroll") for (int n = 0; n < 2; ++n) _Pragma("unroll") for (int k = 0; k < 2; ++k) dst[n][k] = *(const PG8_LAS bf16x8*)(lds + PG8_SB(b, h) + boff + n * 2048 + k * 1024); } while (0)
#define PG8_MMA(ai, bj, At, Bt) do { __builtin_amdgcn_s_setprio(1); _Pragma("unroll") for (int m = 0; m < 4; ++m) _Pragma("unroll") for (int n = 0; n < 2; ++n) _Pragma("unroll") for (int k = 0; k < 2; ++k) \
        acc[ai][bj][m][n] = __builtin_amdgcn_mfma_f32_16x16x32_bf16(Bt[n][k], At[m][k], acc[ai][bj][m][n], 0, 0, 0); __builtin_amdgcn_s_setprio(0); } while (0)
#define PG8_WAIT_V(n) asm volatile("s_waitcnt vmcnt(" #n ")" ::: "memory")
#define PG8_WAIT_L(n) asm volatile("s_waitcnt lgkmcnt(" #n ")" ::: "memory")
#define PG8_BAR __builtin_amdgcn_s_barrier()
#define PG8_SCHED __builtin_amdgcn_sched_barrier(0)
    Unit cur, nxt; int ui = 0;
    if (!S.next(0, cur)) return;
    f32x4 acc[2][2][4][2];
#pragma unroll
    for (int a = 0; a < 2; ++a)
#pragma unroll
        for (int b = 0; b < 2; ++b)
#pragma unroll
            for (int m = 0; m < 4; ++m)
#pragma unroll
                for (int n = 0; n < 2; ++n) acc[a][b][m][n] = (f32x4){0.f, 0.f, 0.f, 0.f};
    bf16x8 At[4][2], B0[2][2], B1[2][2];
    const char* cA = (const char*)g.A + (size_t)cur.pm * tstepA; const char* cB = (const char*)g.Bt + (size_t)cur.pn * tstepB;
    S.a_ready(cur);
    if constexpr (SP2) {
        PG8_STAGE(PG8_SB(0, 0), cB, voffB); PG8_STAGE(PG8_SB(0, 1), cB + hstepB, voffB); PG8_STAGE(PG8_SA(0, 0), cA, voffA); PG8_STAGE(PG8_SA(0, 1), cA + hstepA, voffA);
        if (wr == 1) PG8_BAR;
        PG8_WAIT_V(2); PG8_BAR;
        PG8_STAGE(PG8_SB(1, 0), cB + kstep, voffB); PG8_STAGE(PG8_SA(1, 0), cA + kstep, voffA); PG8_STAGE(PG8_SB(1, 1), cB + hstepB + kstep, voffB);
        PG8_WAIT_V(6); PG8_BAR;
    } else {
        PG8_STAGE(PG8_SB(0, 0), cB, voffB); PG8_STAGE(PG8_SA(0, 0), cA, voffA); PG8_STAGE(PG8_SB(0, 1), cB + hstepB, voffB); PG8_STAGE(PG8_SA(0, 1), cA + hstepA, voffA);
        if (wr == 1) PG8_BAR;
        PG8_WAIT_V(4); PG8_BAR;
        PG8_STAGE(PG8_SB(1, 0), cB + kstep, voffB); PG8_STAGE(PG8_SA(1, 0), cA + kstep, voffA); PG8_STAGE(PG8_SB(1, 1), cB + hstepB + kstep, voffB);
        PG8_WAIT_V(6); PG8_BAR;
    }
    for (;;) {
        const bool has_next = S.next(ui + 1, nxt);
        const char* nA = has_next ? (const char*)g.A + (size_t)nxt.pm * tstepA : cA; const char* nB = has_next ? (const char*)g.Bt + (size_t)nxt.pn * tstepB : cB;
        for (int t = 0; t < nt; t += 2) {
            const bool last = (t == nt - 2);
            const char* a1 = cA + (size_t)(t + 1) * kstep;
            const char* a2 = last ? nA : cA + (size_t)(t + 2) * kstep; const char* b2 = last ? nB : cB + (size_t)(t + 2) * kstep;
            const char* a3 = a2 + kstep; const char* b3 = b2 + kstep;
            if (last && has_next) S.a_ready(nxt);
            if constexpr (SP2) {
            PG8_LDB(B0, 0, 0); PG8_LDB(B1, 0, 1); PG8_SCHED; PG8_LDA(At, 0, 0); PG8_STAGE(PG8_SA(1, 1), a1 + hstepA, voffA);
            PG8_WAIT_V(8); PG8_WAIT_L(0); PG8_BAR; PG8_MMA(0, 0, At, B0); PG8_MMA(0, 1, At, B1); PG8_BAR; PG8_SCHED;
            PG8_LDA(At, 0, 1); PG8_STAGE(PG8_SB(0, 0), b2, voffB); PG8_STAGE(PG8_SB(0, 1), b2 + hstepB, voffB); PG8_STAGE(PG8_SA(0, 0), a2, voffA);
            PG8_WAIT_V(8); PG8_WAIT_L(0); PG8_BAR; PG8_MMA(1, 0, At, B0); PG8_MMA(1, 1, At, B1); PG8_BAR; PG8_SCHED;
            PG8_LDB(B0, 1, 0); PG8_LDB(B1, 1, 1); PG8_SCHED; PG8_LDA(At, 1, 0); PG8_STAGE(PG8_SA(0, 1), a2 + hstepA, voffA);
            PG8_WAIT_V(8); PG8_WAIT_L(0); PG8_BAR; PG8_MMA(0, 0, At, B0); PG8_MMA(0, 1, At, B1); PG8_BAR; PG8_SCHED;
            PG8_LDA(At, 1, 1); PG8_STAGE(PG8_SB(1, 0), b3, voffB); PG8_STAGE(PG8_SB(1, 1), b3 + hstepB, voffB); PG8_STAGE(PG8_SA(1, 0), a3, voffA);
            PG8_WAIT_V(8); PG8_WAIT_L(0); PG8_BAR; PG8_MMA(1, 0, At, B0); PG8_MMA(1, 1, At, B1); PG8_BAR; PG8_SCHED;
            } else {
            PG8_LDB(B0, 0, 0); PG8_SCHED; PG8_LDA(At, 0, 0); PG8_STAGE(PG8_SA(1, 1), a1 + hstepA, voffA);
            PG8_WAIT_L(8); PG8_BAR; PG8_WAIT_L(0); PG8_MMA(0, 0, At, B0); PG8_BAR; PG8_SCHED;
            PG8_LDB(B1, 0, 1); PG8_STAGE(PG8_SB(0, 0), b2, voffB);
            PG8_BAR; PG8_WAIT_L(0); PG8_MMA(0, 1, At, B1); PG8_BAR;
            PG8_LDA(At, 0, 1); PG8_STAGE(PG8_SA(0, 0), a2, voffA);
            PG8_BAR; PG8_WAIT_L(0); PG8_MMA(1, 0, At, B0); PG8_BAR; PG8_SCHED;
            PG8_STAGE(PG8_SB(0, 1), b2 + hstepB, voffB);
            PG8_WAIT_V(6); PG8_BAR; PG8_MMA(1, 1, At, B1); PG8_BAR;
            PG8_LDB(B0, 1, 0); PG8_SCHED; PG8_LDA(At, 1, 0); PG8_STAGE(PG8_SA(0, 1), a2 + hstepA, voffA);
            PG8_WAIT_L(8); PG8_BAR; PG8_WAIT_L(0); PG8_MMA(0, 0, At, B0); PG8_BAR; PG8_SCHED;
            PG8_LDB(B1, 1, 1); PG8_STAGE(PG8_SB(1, 0), b3, voffB);
            PG8_BAR; PG8_WAIT_L(0); PG8_MMA(0, 1, At, B1); PG8_BAR;
            PG8_LDA(At, 1, 1); PG8_STAGE(PG8_SA(1, 0), a3, voffA);
            PG8_BAR; PG8_WAIT_L(0); PG8_MMA(1, 0, At, B0); PG8_BAR; PG8_SCHED;
            PG8_STAGE(PG8_SB(1, 1), b3 + hstepB, voffB);
            PG8_WAIT_V(6); PG8_BAR; PG8_MMA(1, 1, At, B1); PG8_BAR;
            }
        }
        if constexpr (ALIGN_EPI) { if (wr == 0) PG8_BAR; }
        if constexpr (!Epi::AFTER_DRAIN) { E(acc, cur, wr, wc, fr, fq); S.done(cur); }
        if (!has_next) break;
#pragma unroll
        for (int a = 0; a < 2; ++a)
#pragma unroll
            for (int b = 0; b < 2; ++b)
#pragma unroll
                for (int m = 0; m < 4; ++m)
#pragma unroll
                    for (int n = 0; n < 2; ++n) acc[a][b][m][n] = (f32x4){0.f, 0.f, 0.f, 0.f};
        cur = nxt; cA = nA; cB = nB; ++ui;
        if constexpr (ALIGN_EPI) { if (wr == 1) PG8_BAR; }
    }
    PG8_WAIT_V(0);
    if constexpr (!ALIGN_EPI) { if (wr == 0) PG8_BAR; }
    PG8_BAR;
    if constexpr (Epi::AFTER_DRAIN) { E.fused(acc, cur, wr, wc, fr, fq, lds, wid, lane); S.done(cur); }
#undef PG8_SA
#undef PG8_SB
#undef PG8_STAGE
#undef PG8_LDA
#undef PG8_LDB
#undef PG8_MMA
#undef PG8_WAIT_V
#undef PG8_WAIT_L
#undef PG8_BAR
#undef PG8_SCHED
}

}

#define LAS __attribute__((address_space(3)))
typedef unsigned short bf16_t;
typedef unsigned u32;
typedef u32 u32x4 __attribute__((ext_vector_type(4)));
typedef float f32x4 __attribute__((ext_vector_type(4)));
typedef short bf16x8 __attribute__((ext_vector_type(8)));
using pg8::Unit;

constexpr int NB = 16, SEQ = 2048, D = 1024, M = NB * SEQ, PIN = 8704, RGW = 1280, NH = 16, HD = 80, K2 = D + RGW  ;
constexpr float EPS = 1e-6f;
constexpr int NTHR = 512, NWAVES = 8;
constexpr int LDS_BYTES = pg8::STAGE_BYTES;
constexpr size_t MiB = 1024 * 1024;
constexpr size_t WS_WIN = 0, WS_W2 = 18 * MiB, WS_WOUT = 23 * MiB, WS_MOD = 25 * MiB, WS_RSS = 26 * MiB;
constexpr size_t WS_HN = 28 * MiB  , WS_CV = 92 * MiB  , WS_RV = 156 * MiB  , WS_A2 = 236 * MiB  ,
                 WS_GR = 380 * MiB  , WS_GB = 444 * MiB  , WS_END = 508 * MiB;

struct P {
    const float *x, *c, *w_ada, *b_ada, *g_norm, *w_in, *sc_conv_w, *sc_conv_b, *sc_w_out, *rg_conv_w, *rg_conv_b, *rg_w_a, *rg_b_a, *rg_w_x, *rg_b_x, *rg_lambda, *rg_w_out, *b_merge, *w_out, *g_final;
    float* out; unsigned char* ws; int ph_lo, ph_hi;
};

__device__ __forceinline__ u32 pk2(float lo, float hi) { return pg8::cvt_pk_bf16(lo, hi); }
__device__ __forceinline__ float bf_lo(u32 w) { return __uint_as_float(w << 16); }
__device__ __forceinline__ float bf_hi(u32 w) { return __uint_as_float(w & 0xffff0000u); }
__device__ __forceinline__ float sigm(float v) { return __builtin_amdgcn_rcpf(1.f + __expf(-v)); }
__device__ __forceinline__ float silu(float v) { return v * sigm(v); }
__device__ __forceinline__ float wave_sum(float v) {
#pragma unroll
    for (int o = 1; o < 64; o <<= 1) v += __shfl_xor(v, o);
    return v;
}
#define LDS_WAIT() asm volatile("s_waitcnt lgkmcnt(0)" ::: "memory")

struct EpiIn {
    static constexpr bool PERM = true, AFTER_DRAIN = false;
    bf16_t *CV, *A2, *RV, *GR, *GB; const float* bm;
    __device__ __forceinline__ void operator()(const f32x4 (&acc)[2][2][4][2], const Unit& u, int wr, int wc, int fr, int fq) const {
        const int row0 = u.pm * 256 + wr * 64 + fr, jj = wc * 32 + 8 * fq, pn = u.pn;
        if (pn < 8) {
            const int col = pn * 128 + jj;
#pragma unroll
            for (int ai = 0; ai < 2; ++ai)
#pragma unroll
                for (int m = 0; m < 4; ++m) { const size_t r = (size_t)(row0 + ai * 128 + m * 16);
                    const f32x4 X0 = acc[ai][0][m][0], X1 = acc[ai][0][m][1], Y0 = acc[ai][1][m][0], Y1 = acc[ai][1][m][1];
                    u32x4 w; w.x = pk2(X0[0] * Y0[0], X0[1] * Y0[1]); w.y = pk2(X0[2] * Y0[2], X0[3] * Y0[3]); w.z = pk2(X1[0] * Y1[0], X1[1] * Y1[1]); w.w = pk2(X1[2] * Y1[2], X1[3] * Y1[3]);
                    *(u32x4*)(CV + r * D + col) = w; }
        } else if (pn < 16) {
            const int col = (pn - 8) * 128 + jj;
#pragma unroll
            for (int ai = 0; ai < 2; ++ai)
#pragma unroll
                for (int m = 0; m < 4; ++m) { const size_t r = (size_t)(row0 + ai * 128 + m * 16);
                    const f32x4 X0 = acc[ai][0][m][0], X1 = acc[ai][0][m][1], Y0 = acc[ai][1][m][0], Y1 = acc[ai][1][m][1];
                    u32x4 w; w.x = pk2(X0[0] * silu(Y0[0]), X0[1] * silu(Y0[1])); w.y = pk2(X0[2] * silu(Y0[2]), X0[3] * silu(Y0[3]));
                    w.z = pk2(X1[0] * silu(Y1[0]), X1[1] * silu(Y1[1])); w.w = pk2(X1[2] * silu(Y1[2]), X1[3] * silu(Y1[3]));
                    *(u32x4*)(A2 + r * K2 + col) = w; }
        } else if (pn < 26) {
            const int col = (pn - 16) * 128 + jj;
#pragma unroll
            for (int ai = 0; ai < 2; ++ai)
#pragma unroll
                for (int m = 0; m < 4; ++m) { const size_t r = (size_t)(row0 + ai * 128 + m * 16);
                    const f32x4 X0 = acc[ai][0][m][0], X1 = acc[ai][0][m][1], Y0 = acc[ai][1][m][0], Y1 = acc[ai][1][m][1];
                    u32x4 w; w.x = pk2(X0[0], X0[1]); w.y = pk2(X0[2], X0[3]); w.z = pk2(X1[0], X1[1]); w.w = pk2(X1[2], X1[3]);
                    *(u32x4*)(RV + r * RGW + col) = w;
                    u32x4 s; s.x = pk2(silu(Y0[0]), silu(Y0[1])); s.y = pk2(silu(Y0[2]), silu(Y0[3])); s.z = pk2(silu(Y1[0]), silu(Y1[1])); s.w = pk2(silu(Y1[2]), silu(Y1[3]));
                    *(u32x4*)(A2 + r * K2 + D + col) = s; }
        } else {
            const int col = (pn - 26) * 128 + jj;
            const f32x4 ba0 = *(const f32x4*)(bm + col), ba1 = *(const f32x4*)(bm + col + 4), bb0 = *(const f32x4*)(bm + D + col), bb1 = *(const f32x4*)(bm + D + col + 4);
#pragma unroll
            for (int ai = 0; ai < 2; ++ai)
#pragma unroll
                for (int m = 0; m < 4; ++m) { const size_t r = (size_t)(row0 + ai * 128 + m * 16);
                    const f32x4 X0 = acc[ai][0][m][0] + ba0, X1 = acc[ai][0][m][1] + ba1, Y0 = acc[ai][1][m][0] + bb0, Y1 = acc[ai][1][m][1] + bb1;
                    float gr[8], gb[8];
#pragma unroll
                    for (int e = 0; e < 4; ++e) { const float ea0 = 1.f + __expf(-X0[e]), eb0 = 1.f + __expf(-Y0[e]), ea1 = 1.f + __expf(-X1[e]), eb1 = 1.f + __expf(-Y1[e]);
                        gb[e] = __builtin_amdgcn_rcpf(eb0); gr[e] = __builtin_amdgcn_rcpf(ea0); gb[4 + e] = __builtin_amdgcn_rcpf(eb1); gr[4 + e] = __builtin_amdgcn_rcpf(ea1); }
                    u32x4 w; w.x = pk2(gr[0], gr[1]); w.y = pk2(gr[2], gr[3]); w.z = pk2(gr[4], gr[5]); w.w = pk2(gr[6], gr[7]);
                    *(u32x4*)(GR + r * D + col) = w;
                    u32x4 s; s.x = pk2(gb[0], gb[1]); s.y = pk2(gb[2], gb[3]); s.z = pk2(gb[4], gb[5]); s.w = pk2(gb[6], gb[7]);
                    *(u32x4*)(GB + r * D + col) = s; }
        }
    }
};
template <bool ADD> struct EpiMerge {
    static constexpr bool PERM = true, AFTER_DRAIN = false;
    const bf16_t* GG; bf16_t* MRG;
    __device__ __forceinline__ void operator()(const f32x4 (&acc)[2][2][4][2], const Unit& u, int wr, int wc, int fr, int fq) const {
        const int row0 = u.pm * 256 + wr * 64 + fr, col0 = u.pn * 256 + wc * 32 + 8 * fq;
#pragma unroll
        for (int ai = 0; ai < 2; ++ai)
#pragma unroll
            for (int m = 0; m < 4; ++m) { const size_t r = (size_t)(row0 + ai * 128 + m * 16);
#pragma unroll
                for (int bj = 0; bj < 2; ++bj) { const u32x4 g = *(const u32x4*)(GG + r * D + col0 + bj * 128); const f32x4 v0 = acc[ai][bj][m][0], v1 = acc[ai][bj][m][1];
                    float o[8] = {v0[0] * bf_lo(g.x), v0[1] * bf_hi(g.x), v0[2] * bf_lo(g.y), v0[3] * bf_hi(g.y), v1[0] * bf_lo(g.z), v1[1] * bf_hi(g.z), v1[2] * bf_lo(g.w), v1[3] * bf_hi(g.w)};
                    if (ADD) { const u32x4 t = *(const u32x4*)(MRG + r * D + col0 + bj * 128);
                        o[0] += bf_lo(t.x); o[1] += bf_hi(t.x); o[2] += bf_lo(t.y); o[3] += bf_hi(t.y); o[4] += bf_lo(t.z); o[5] += bf_hi(t.z); o[6] += bf_lo(t.w); o[7] += bf_hi(t.w); }
                    u32x4 w; w.x = pk2(o[0], o[1]); w.y = pk2(o[2], o[3]); w.z = pk2(o[4], o[5]); w.w = pk2(o[6], o[7]);
                    *(u32x4*)(MRG + r * D + col0 + bj * 128) = w; } }
    }
};
struct EpiOut {
    static constexpr bool PERM = false, AFTER_DRAIN = false;
    const float *x, *mod; float *out, *rss;
    __device__ __forceinline__ void operator()(const f32x4 (&acc)[2][2][4][2], const Unit& u, int wr, int wc, int fr, int fq) const {
        const int row0 = u.pm * 256 + wr * 64 + fr, col0 = u.pn * 256 + wc * 32 + 4 * fq, b = u.pm >> 3;
        const float* gate = mod + (size_t)b * 3 * D + 2 * D + col0;
        f32x4 gv[2][2];
#pragma unroll
        for (int bj = 0; bj < 2; ++bj)
#pragma unroll
            for (int n = 0; n < 2; ++n) gv[bj][n] = *(const f32x4*)(gate + bj * 128 + n * 16);
#pragma unroll
        for (int ai = 0; ai < 2; ++ai)
#pragma unroll
            for (int m = 0; m < 4; ++m) { const size_t r = (size_t)(row0 + ai * 128 + m * 16); float ss = 0.f;
#pragma unroll
                for (int bj = 0; bj < 2; ++bj)
#pragma unroll
                    for (int n = 0; n < 2; ++n) { const f32x4 xv = *(const f32x4*)(x + r * D + col0 + bj * 128 + n * 16); const f32x4 o = xv + gv[bj][n] * acc[ai][bj][m][n];
                        *(f32x4*)(out + r * D + col0 + bj * 128 + n * 16) = o; ss += (o[0] * o[0] + o[1] * o[1]) + (o[2] * o[2] + o[3] * o[3]); }
                ss += __shfl_xor(ss, 16); ss += __shfl_xor(ss, 32);
                if (fq == 0) rss[(size_t)(u.pn * 4 + wc) * M + r] = ss; }
    }
};

__device__ __forceinline__ void tr_item(const float* W, int N, int k0, int n0, bf16_t* WT, int ldk, int drow0, int dk0, LAS float* scr, int lane) {
#pragma unroll 8
    for (int i = 0; i < 32; ++i) { const int kk = 2 * i + (lane >> 5); scr[kk * 33 + (lane & 31)] = W[(size_t)(k0 + kk) * N + n0 + (lane & 31)]; }
    LDS_WAIT();
    const int c = lane & 7;
#pragma unroll
    for (int j = 0; j < 4; ++j) { const int n = (lane >> 3) + 8 * j; const LAS float* s = scr + (8 * c) * 33 + n;
        u32x4 o; o.x = pk2(s[0 * 33], s[1 * 33]); o.y = pk2(s[2 * 33], s[3 * 33]); o.z = pk2(s[4 * 33], s[5 * 33]); o.w = pk2(s[6 * 33], s[7 * 33]);
        *(u32x4*)(WT + (size_t)(drow0 + n) * ldk + dk0 + 8 * c) = o; }
    LDS_WAIT();
}
__device__ __forceinline__ int src_col_of_tile(int pn, int half) {
    if (pn < 8) return (half ? 2048 : 1024) + pn * 128;
    if (pn < 16) return (half ? 3072 : 0) + (pn - 8) * 128;
    if (pn < 26) return (half ? 5376 : 4096) + (pn - 16) * 128;
    return (half ? 7680 : 6656) + (pn - 26) * 128;
}
__device__ __forceinline__ void phase_prep(const P& p, LAS unsigned char* lds) {
    const int tid = threadIdx.x, lane = tid & 63, wave = tid >> 6, G = gridDim.x;
    bf16_t* Win_t = (bf16_t*)(p.ws + WS_WIN); bf16_t* W2_t = (bf16_t*)(p.ws + WS_W2); bf16_t* Wout_t = (bf16_t*)(p.ws + WS_WOUT); float* mod = (float*)(p.ws + WS_MOD);
    for (int it = blockIdx.x; it < 48; it += G) {
        LAS float* cs = (LAS float*)lds;
        LAS float* red = (LAS float*)(lds + 65536);
        for (int i = tid; i < NB * D; i += NTHR) cs[i] = silu(p.c[i]);
        __syncthreads();
        const int col = it * 64 + lane, kp = wave;
        float a[16];
#pragma unroll
        for (int b = 0; b < 16; ++b) a[b] = 0.f;
        for (int k = kp * 128; k < kp * 128 + 128; k += 4) {
            const float w0 = p.w_ada[(size_t)(k + 0) * 3 * D + col], w1 = p.w_ada[(size_t)(k + 1) * 3 * D + col], w2 = p.w_ada[(size_t)(k + 2) * 3 * D + col], w3 = p.w_ada[(size_t)(k + 3) * 3 * D + col];
#pragma unroll
            for (int b = 0; b < 16; ++b) { const f32x4 cv = *(const LAS f32x4*)(cs + b * D + k); a[b] += cv[0] * w0 + cv[1] * w1 + cv[2] * w2 + cv[3] * w3; }
        }
#pragma unroll
        for (int b = 0; b < 16; ++b) red[(kp * 16 + b) * 64 + lane] = a[b];
        __syncthreads();
        for (int o = tid; o < 16 * 64; o += NTHR) { const int b = o >> 6, cc = o & 63; float s = p.b_ada[it * 64 + cc];
#pragma unroll
            for (int q = 0; q < 8; ++q) s += red[(q * 16 + b) * 64 + cc];
            mod[b * 3 * D + it * 64 + cc] = s; }
        __syncthreads();
    }
    LAS float* scr = (LAS float*)(lds + wave * 16384);
    const int gw = blockIdx.x * NWAVES + wave, NGW = G * NWAVES;
    constexpr int I_IN = 16 * 272, I_A = 16 * 32, I_B = 20 * 32, I_O = 16 * 32, NIT = I_IN + I_A + I_B + I_O;
    for (int it = gw; it < NIT; it += NGW) {
        int r = it;
        if (r < I_IN) { const int kb = r / 272, nbp = r % 272, pn = nbp >> 3, half = (nbp >> 2) & 1, sub = nbp & 3;
            tr_item(p.w_in, PIN, kb * 64, src_col_of_tile(pn, half) + sub * 32, Win_t, D, nbp * 32, kb * 64, scr, lane); continue; }
        r -= I_IN;
        if (r < I_A) { const int kb = r >> 5, nb = r & 31; tr_item(p.sc_w_out, D, kb * 64, nb * 32, W2_t, K2, nb * 32, kb * 64, scr, lane); continue; }
        r -= I_A;
        if (r < I_B) { const int kb = r >> 5, nb = r & 31; tr_item(p.rg_w_out, D, kb * 64, nb * 32, W2_t, K2, nb * 32, D + kb * 64, scr, lane); continue; }
        r -= I_B;
        { const int kb = r >> 5, nb = r & 31; tr_item(p.w_out, D, kb * 64, nb * 32, Wout_t, D, nb * 32, kb * 64, scr, lane); }
    }
    __syncthreads();
}

__device__ __forceinline__ void phase_h(const P& p) {
    const int tid = threadIdx.x, lane = tid & 63, wave = tid >> 6, G = gridDim.x;
    const float* mod = (const float*)(p.ws + WS_MOD); bf16_t* HN = (bf16_t*)(p.ws + WS_HN);
    for (int r0 = (blockIdx.x * NWAVES + wave) * 16; r0 < M; r0 += G * NWAVES * 16) {
        const int b = r0 >> 11;
        f32x4 gs[4], sh[4];
#pragma unroll
        for (int j = 0; j < 4; ++j) { const int c = 4 * lane + 256 * j; const f32x4 g = *(const f32x4*)(p.g_norm + c), sc = *(const f32x4*)(mod + b * 3 * D + D + c);
            gs[j] = g * (sc + 1.0f); sh[j] = *(const f32x4*)(mod + b * 3 * D + c); }
        for (int i = 0; i < 16; ++i) { const size_t r = (size_t)(r0 + i);
            f32x4 v[4]; float s = 0.f;
#pragma unroll
            for (int j = 0; j < 4; ++j) { v[j] = *(const f32x4*)(p.x + r * D + 4 * lane + 256 * j); s += (v[j][0] * v[j][0] + v[j][1] * v[j][1]) + (v[j][2] * v[j][2] + v[j][3] * v[j][3]); }
            const float rstd = 1.0f / sqrtf(wave_sum(s) * (1.0f / D) + EPS);
#pragma unroll
            for (int j = 0; j < 4; ++j) { const f32x4 o = v[j] * rstd * gs[j] + sh[j];
                unsigned long long w = (unsigned long long)pk2(o[0], o[1]) | ((unsigned long long)pk2(o[2], o[3]) << 32);
                *(unsigned long long*)(HN + r * D + 4 * lane + 256 * j) = w; }
        }
    }
}

__device__ __forceinline__ void phase_convgate(const P& p) {
    const int tid = threadIdx.x, G = gridDim.x;
    const bf16_t* CV = (const bf16_t*)(p.ws + WS_CV); bf16_t* A2 = (bf16_t*)(p.ws + WS_A2);
    const int c0 = (tid & 127) * 8, run = tid >> 7;
    float w0[8], w1[8], w2[8], cb[8];
#pragma unroll
    for (int e = 0; e < 8; ++e) { w0[e] = p.sc_conv_w[c0 + e]; w1[e] = p.sc_conv_w[D + c0 + e]; w2[e] = p.sc_conv_w[2 * D + c0 + e]; cb[e] = p.sc_conv_b[c0 + e]; }
    for (int it = blockIdx.x; it < M / 128; it += G) {
        const size_t T0 = (size_t)it * 128 + run * 32;
        float c2[8], c1[8];
        if ((T0 & (SEQ - 1)) == 0) {
#pragma unroll
            for (int e = 0; e < 8; ++e) { c2[e] = 0.f; c1[e] = 0.f; }
        } else {
            const u32x4 a = *(const u32x4*)(CV + (T0 - 2) * D + c0), bq = *(const u32x4*)(CV + (T0 - 1) * D + c0);
            c2[0] = bf_lo(a.x); c2[1] = bf_hi(a.x); c2[2] = bf_lo(a.y); c2[3] = bf_hi(a.y); c2[4] = bf_lo(a.z); c2[5] = bf_hi(a.z); c2[6] = bf_lo(a.w); c2[7] = bf_hi(a.w);
            c1[0] = bf_lo(bq.x); c1[1] = bf_hi(bq.x); c1[2] = bf_lo(bq.y); c1[3] = bf_hi(bq.y); c1[4] = bf_lo(bq.z); c1[5] = bf_hi(bq.z); c1[6] = bf_lo(bq.w); c1[7] = bf_hi(bq.w);
        }
#pragma unroll 4
        for (int t = 0; t < 32; ++t) {
            const u32x4 cq = *(const u32x4*)(CV + (T0 + t) * D + c0); const u32x4 bg = *(const u32x4*)(A2 + (T0 + t) * K2 + c0);
            float cu[8], bv[8], o[8];
            cu[0] = bf_lo(cq.x); cu[1] = bf_hi(cq.x); cu[2] = bf_lo(cq.y); cu[3] = bf_hi(cq.y); cu[4] = bf_lo(cq.z); cu[5] = bf_hi(cq.z); cu[6] = bf_lo(cq.w); cu[7] = bf_hi(cq.w);
            bv[0] = bf_lo(bg.x); bv[1] = bf_hi(bg.x); bv[2] = bf_lo(bg.y); bv[3] = bf_hi(bg.y); bv[4] = bf_lo(bg.z); bv[5] = bf_hi(bg.z); bv[6] = bf_lo(bg.w); bv[7] = bf_hi(bg.w);
#pragma unroll
            for (int e = 0; e < 8; ++e) { o[e] = bv[e] * (cb[e] + w0[e] * c2[e] + w1[e] * c1[e] + w2[e] * cu[e]); c2[e] = c1[e]; c1[e] = cu[e]; }
            u32x4 w; w.x = pk2(o[0], o[1]); w.y = pk2(o[2], o[3]); w.z = pk2(o[4], o[5]); w.w = pk2(o[6], o[7]);
            *(u32x4*)(A2 + (T0 + t) * K2 + c0) = w;
        }
    }
}

constexpr int RG_LD = 104;
constexpr int RG_TT = 128;
constexpr int RG_WT = 0, RG_PRM = 33280, RG_VB = 36864, RG_COMP = RG_VB + RG_TT * RG_LD * 2, RG_HST = RG_COMP + 8 * 80 * 2 * 4;
__device__ __forceinline__ void phase_rglru(const P& p, LAS unsigned char* lds) {
    const int tid = threadIdx.x, lane = tid & 63, wave = tid >> 6, fr = lane & 15, fq = lane >> 4, G = gridDim.x;
    const bf16_t* RV = (const bf16_t*)(p.ws + WS_RV); bf16_t* A2 = (bf16_t*)(p.ws + WS_A2);
    LAS bf16_t* WT = (LAS bf16_t*)(lds + RG_WT);
    LAS float* PRM = (LAS float*)(lds + RG_PRM);
    LAS bf16_t* VB = (LAS bf16_t*)(lds + RG_VB);
    LAS float* COMP = (LAS float*)(lds + RG_COMP);
    LAS float* HST = (LAS float*)(lds + RG_HST);
    for (int item = blockIdx.x; item < NB * NH; item += G) {
        const int b = item >> 4, h = item & 15;
        for (int idx = tid; idx < 2 * 6400; idx += NTHR) { const int g = idx / 6400, rem = idx - g * 6400, d = rem / 80, e = rem - d * 80;
            const float v = (g ? p.rg_w_x : p.rg_w_a)[h * 6400 + rem]; WT[(g * 80 + e) * RG_LD + d] = (bf16_t)(pk2(v, 0.f) & 0xffffu); }
        for (int idx = tid; idx < 160 * 16; idx += NTHR) WT[(idx >> 4) * RG_LD + 80 + (idx & 15)] = 0;
        for (int idx = tid; idx < RG_TT * 16; idx += NTHR) VB[(idx >> 4) * RG_LD + 80 + (idx & 15)] = 0;
        if (tid < 80) { const int ch = h * 80 + tid;
#pragma unroll
            for (int k = 0; k < 4; ++k) PRM[k * 80 + tid] = p.rg_conv_w[k * RGW + ch];
            PRM[4 * 80 + tid] = p.rg_conv_b[ch]; PRM[5 * 80 + tid] = p.rg_b_a[ch]; PRM[6 * 80 + tid] = p.rg_b_x[ch];
            PRM[7 * 80 + tid] = 8.0f * log1pf(expf(-p.rg_lambda[ch])); HST[tid] = 0.f; }
        __syncthreads();
#pragma unroll 1
        for (int tt = 0; tt < SEQ / RG_TT; ++tt) {
            const int s0 = tt * RG_TT; const size_t R0 = (size_t)b * SEQ + s0;
#pragma unroll 1
            for (int pidx = tid; pidx < RG_TT * 10; pidx += NTHR) {
                const int t = pidx / 10, c = pidx - t * 10, s = s0 + t;
                const bf16_t* src = RV + (R0 + t) * RGW + h * 80 + c * 8;
                const u32x4 z4 = {0u, 0u, 0u, 0u};
                const u32x4 r3 = *(const u32x4*)src, r2 = s >= 1 ? *(const u32x4*)(src - RGW) : z4, r1 = s >= 2 ? *(const u32x4*)(src - 2 * RGW) : z4, r0 = s >= 3 ? *(const u32x4*)(src - 3 * RGW) : z4;
                float o[8];
#pragma unroll
                for (int hh = 0; hh < 2; ++hh) {
                    const f32x4 k0 = *(const LAS f32x4*)(PRM + 0 * 80 + c * 8 + 4 * hh), k1 = *(const LAS f32x4*)(PRM + 1 * 80 + c * 8 + 4 * hh), k2 = *(const LAS f32x4*)(PRM + 2 * 80 + c * 8 + 4 * hh),
                                k3 = *(const LAS f32x4*)(PRM + 3 * 80 + c * 8 + 4 * hh), kb = *(const LAS f32x4*)(PRM + 4 * 80 + c * 8 + 4 * hh);
                    const u32 a0 = hh ? r0.z : r0.x, a1 = hh ? r0.w : r0.y, b0 = hh ? r1.z : r1.x, b1 = hh ? r1.w : r1.y, c0 = hh ? r2.z : r2.x, c1 = hh ? r2.w : r2.y, d0 = hh ? r3.z : r3.x, d1 = hh ? r3.w : r3.y;
                    o[4 * hh + 0] = kb[0] + k0[0] * bf_lo(a0) + k1[0] * bf_lo(b0) + k2[0] * bf_lo(c0) + k3[0] * bf_lo(d0);
                    o[4 * hh + 1] = kb[1] + k0[1] * bf_hi(a0) + k1[1] * bf_hi(b0) + k2[1] * bf_hi(c0) + k3[1] * bf_hi(d0);
                    o[4 * hh + 2] = kb[2] + k0[2] * bf_lo(a1) + k1[2] * bf_lo(b1) + k2[2] * bf_lo(c1) + k3[2] * bf_lo(d1);
                    o[4 * hh + 3] = kb[3] + k0[3] * bf_hi(a1) + k1[3] * bf_hi(b1) + k2[3] * bf_hi(c1) + k3[3] * bf_hi(d1);
                }
                u32x4 w; w.x = pk2(o[0], o[1]); w.y = pk2(o[2], o[3]); w.z = pk2(o[4], o[5]); w.w = pk2(o[6], o[7]);
                *(LAS u32x4*)(VB + t * RG_LD + c * 8) = w;
            }
            __syncthreads();
            const int t0 = wave * 16;
            bf16_t* const obase = A2 + (R0 + t0 + fq * 4) * K2 + D + h * 80 + fr;
            float hl[5][4], ca[5][4], Aw[5], Hw[5];
            {
                f32x4 acc[2][5];
#pragma unroll
                for (int g = 0; g < 2; ++g)
#pragma unroll
                    for (int n = 0; n < 5; ++n) acc[g][n] = (f32x4){0.f, 0.f, 0.f, 0.f};
#pragma unroll
                for (int ks = 0; ks < 3; ++ks) {
                    const bf16x8 af = *(const LAS bf16x8*)(VB + (t0 + fr) * RG_LD + ks * 32 + fq * 8);
#pragma unroll
                    for (int g = 0; g < 2; ++g)
#pragma unroll
                        for (int n = 0; n < 5; ++n) { const bf16x8 bfm = *(const LAS bf16x8*)(WT + (g * 80 + n * 16 + fr) * RG_LD + ks * 32 + fq * 8);
                            acc[g][n] = __builtin_amdgcn_mfma_f32_16x16x32_bf16(af, bfm, acc[g][n], 0, 0, 0); }
                }
#pragma unroll
                for (int n = 0; n < 5; ++n) {
                    const int ch = n * 16 + fr; const float ba = PRM[5 * 80 + ch], bx = PRM[6 * 80 + ch], c8 = PRM[7 * 80 + ch];
                    float A = 1.f, H = 0.f;
#pragma unroll
                    for (int rg = 0; rg < 4; ++rg) {
                        const float v = __uint_as_float(((u32)VB[(t0 + fq * 4 + rg) * RG_LD + ch]) << 16);
                        const float r = sigm(acc[0][n][rg] + ba), ig = sigm(acc[1][n][rg] + bx);
                        const float la = -r * c8, a = __expf(la), x2 = 2.f * la;
                        const float om = -x2 * (1.f + x2 * (0.5f + x2 * (0.16666667f + x2 * (0.041666668f + x2 * 0.0083333338f))));
                        const float bt = sqrtf(om) * (ig * v);
                        H = a * H + bt; A *= a; hl[n][rg] = H; ca[n][rg] = A;
                    }
                    float Ap = __shfl_up(A, 16), Hp = __shfl_up(H, 16); if (fq >= 1) { H = A * Hp + H; A = Ap * A; }
                    Ap = __shfl_up(A, 32); Hp = __shfl_up(H, 32); if (fq >= 2) { H = A * Hp + H; A = Ap * A; }
                    float Ae = __shfl_up(A, 16), He = __shfl_up(H, 16); if (fq == 0) { Ae = 1.f; He = 0.f; }
                    Aw[n] = __shfl(A, 48 + fr); Hw[n] = __shfl(H, 48 + fr);
#pragma unroll
                    for (int rg = 0; rg < 4; ++rg) { hl[n][rg] += ca[n][rg] * He; ca[n][rg] *= Ae; }
                }
            }
            if (fq == 0) {
#pragma unroll
                for (int n = 0; n < 5; ++n) { COMP[(wave * 80 + n * 16 + fr) * 2 + 0] = Aw[n]; COMP[(wave * 80 + n * 16 + fr) * 2 + 1] = Hw[n]; }
            }
            bf16_t sgv[5][4];
#pragma unroll
            for (int rg = 0; rg < 4; ++rg) { const bf16_t* rowp = obase + rg * K2;
#pragma unroll
                for (int n = 0; n < 5; ++n) sgv[n][rg] = rowp[n * 16]; }
            __syncthreads();
            float hin[5];
#pragma unroll
            for (int n = 0; n < 5; ++n) hin[n] = HST[(tt & 1) * 80 + n * 16 + fr];
#pragma unroll 1
            for (int w = 0; w < wave; ++w) {
#pragma unroll
                for (int n = 0; n < 5; ++n) { const int ch = n * 16 + fr; hin[n] = COMP[(w * 80 + ch) * 2 + 0] * hin[n] + COMP[(w * 80 + ch) * 2 + 1]; }
            }
            if (wave == 7 && fq == 0) {
#pragma unroll
                for (int n = 0; n < 5; ++n) HST[((tt + 1) & 1) * 80 + n * 16 + fr] = Aw[n] * hin[n] + Hw[n];
            }
#pragma unroll
            for (int rg = 0; rg < 4; ++rg) { bf16_t* rowp = obase + rg * K2;
#pragma unroll
                for (int n = 0; n < 5; ++n) { const float y = hl[n][rg] + ca[n][rg] * hin[n]; const float o = y * __uint_as_float(((u32)sgv[n][rg]) << 16);
                    rowp[n * 16] = (bf16_t)(pk2(o, 0.f) & 0xffffu); } }
        }
        __syncthreads();
    }
}

__device__ __forceinline__ void phase_final(const P& p) {
    const int tid = threadIdx.x, lane = tid & 63, wave = tid >> 6, G = gridDim.x;
    const float* rss = (const float*)(p.ws + WS_RSS);
    f32x4 gf[4];
#pragma unroll
    for (int j = 0; j < 4; ++j) gf[j] = *(const f32x4*)(p.g_final + 4 * lane + 256 * j);
    for (int r0 = (blockIdx.x * NWAVES + wave) * 16; r0 < M; r0 += G * NWAVES * 16) {
        for (int i = 0; i < 16; ++i) { const size_t r = (size_t)(r0 + i);
            float s = 0.f;
#pragma unroll
            for (int q = 0; q < 16; ++q) s += rss[(size_t)q * M + r];
            const float rstd = 1.0f / sqrtf(s * (1.0f / D) + EPS);
#pragma unroll
            for (int j = 0; j < 4; ++j) { float* o = p.out + r * D + 4 * lane + 256 * j; const f32x4 v = *(const f32x4*)o; *(f32x4*)o = v * rstd * gf[j]; }
        }
    }
}

__global__ void __launch_bounds__(NTHR, 2) fwd_kernel(P p) {
    extern __shared__ __attribute__((aligned(16))) unsigned char lds_raw[];
    LAS unsigned char* lds = (LAS unsigned char*)lds_raw;
    cg::grid_group grid = cg::this_grid();
    const int G = gridDim.x;
    bf16_t* Win_t = (bf16_t*)(p.ws + WS_WIN); bf16_t* W2_t = (bf16_t*)(p.ws + WS_W2); bf16_t* Wout_t = (bf16_t*)(p.ws + WS_WOUT);
    bf16_t* HN = (bf16_t*)(p.ws + WS_HN); bf16_t* MRG = HN; bf16_t* CV = (bf16_t*)(p.ws + WS_CV); bf16_t* RV = (bf16_t*)(p.ws + WS_RV); bf16_t* A2 = (bf16_t*)(p.ws + WS_A2);
    bf16_t* GR = (bf16_t*)(p.ws + WS_GR); bf16_t* GB = (bf16_t*)(p.ws + WS_GB);
#ifndef PHMASK
#define PHMASK 127
#endif
#define IN(k) (((PHMASK >> (k)) & 1) && p.ph_lo <= (k) && (k) < p.ph_hi)
#define SEAM(k) do { if (IN(k) && IN((k) + 1)) grid.sync(); } while (0)
    if (IN(0)) phase_prep(p, lds);
    SEAM(0);
    if (IN(1)) phase_h(p);
    SEAM(1);
    if (IN(2)) { pg8::Gemm g{HN, Win_t, M, PIN, D, D, D}; pg8::StaticOrder S; S.init(M, PIN, G, (int)blockIdx.x);
        EpiIn E{CV, A2, RV, GR, GB, p.b_merge};
        pg8::gemm_phase<EpiIn, pg8::StaticOrder, true, true>(lds, g, S, E); }
    SEAM(2);
    if (IN(3)) {
#ifndef NO_CG
        phase_convgate(p);
#endif
#ifndef NO_RG
        phase_rglru(p, lds);
#endif
    }
    SEAM(3);
    if (IN(4)) { pg8::StaticOrder S; S.init(M, D, G, (int)blockIdx.x);
        { pg8::Gemm g{A2, W2_t, M, D, D, K2, K2}; EpiMerge<false> E{GR, MRG}; pg8::gemm_phase<EpiMerge<false>, pg8::StaticOrder, true, true>(lds, g, S, E); }
        { pg8::Gemm g{A2 + D, W2_t + D, M, D, RGW, K2, K2}; EpiMerge<true> E{GB, MRG}; pg8::gemm_phase<EpiMerge<true>, pg8::StaticOrder, true, true>(lds, g, S, E); } }
    SEAM(4);
    if (IN(5)) { pg8::Gemm g{MRG, Wout_t, M, D, D, D, D}; pg8::StaticOrder S; S.init(M, D, G, (int)blockIdx.x);
        EpiOut E{p.x, (const float*)(p.ws + WS_MOD), p.out, (float*)(p.ws + WS_RSS)};
        pg8::gemm_phase<EpiOut, pg8::StaticOrder, true, true>(lds, g, S, E); }
    SEAM(5);
    if (IN(6)) phase_final(p);
#undef IN
#undef SEAM
}

extern "C" void kernel_launch(void* const* d_in, const int* in_sizes, int n_in, void* d_out, int out_size, void* d_ws, size_t ws_size, hipStream_t stream) {
    static int grid = 0;
    if (grid == 0) {
        if (n_in != 20 || out_size != M * D || ws_size < WS_END) { fprintf(stderr, "kernel_launch: unexpected shapes (n_in %d, out %d, ws %zu)\n", n_in, out_size, ws_size); grid = -1; return; }
        int dev = 0, cus = 0, per_cu = 0;
        (void)hipGetDevice(&dev); (void)hipDeviceGetAttribute(&cus, hipDeviceAttributeMultiprocessorCount, dev);
        if (hipFuncSetAttribute((const void*)fwd_kernel, hipFuncAttributeMaxDynamicSharedMemorySize, LDS_BYTES) != hipSuccess) { fprintf(stderr, "kernel_launch: hipFuncSetAttribute failed\n"); grid = -1; return; }
        if (hipOccupancyMaxActiveBlocksPerMultiprocessor(&per_cu, (const void*)fwd_kernel, NTHR, LDS_BYTES) != hipSuccess || per_cu < 1) { fprintf(stderr, "kernel_launch: occupancy query says %d blocks per CU\n", per_cu); per_cu = 1; }
        (void)hipGetLastError();
        if (cus <= 0) cus = 256;
        grid = cus * 1;
    }
    if (grid < 0) return;
    P p{};
    const float** dst = (const float**)&p;
    for (int i = 0; i < 20; ++i) dst[i] = (const float*)d_in[i];
    p.out = (float*)d_out; p.ws = (unsigned char*)d_ws;
#if N_LAUNCHES == 1
    p.ph_lo = 0; p.ph_hi = 7;
    void* args[] = {&p};
    hipError_t e = hipLaunchCooperativeKernel((const void*)fwd_kernel, dim3(grid), dim3(NTHR), args, LDS_BYTES, stream);
    if (e != hipSuccess) fprintf(stderr, "kernel_launch: cooperative launch failed: %s (grid %d)\n", hipGetErrorString(e), grid);
#else
    for (int k = 0; k < 7; ++k) { p.ph_lo = k; p.ph_hi = k + 1; hipLaunchKernelGGL(fwd_kernel, dim3(grid), dim3(NTHR), LDS_BYTES, stream, p); }
#endif
}
```

```cpp
#include <hip/hip_runtime.h>
#include <hip/hip_cooperative_groups.h>
#include <cstdio>
#include <cstdint>
namespace cg = cooperative_groups;

#ifndef N_LAUNCHES
#define N_LAUNCHES 1
#endif

namespace pg8 {
#define PG8_LAS __attribute__((address_space(3)))
typedef unsigned short bf16_t;
typedef short bf16x8 __attribute__((ext_vector_type(8)));
typedef float f32x4 __attribute__((ext_vector_type(4)));
typedef unsigned u32x4 __attribute__((ext_vector_type(4)));
constexpr int BM = 256, BK = 64, HALF = 128, HTB = HALF * BK * 2  , STAGE_BYTES = 8 * HTB, NXCD = 8, WGM = 8;

__host__ __device__ __forceinline__ int lds_byte(int r, int c) { const int st = (r >> 4) * 2 + (c >> 5), rr = r & 15, cc = c & 31, ob = rr * 64 + cc * 2; return st * 1024 + (ob ^ (((ob >> 9) & 1) << 5)); }
__host__ __device__ __forceinline__ void stage_rc(int b, int& R, int& C) { const int st = b / 1024, sb = b % 1024, swz = sb ^ (((sb >> 9) & 1) << 5); R = (st >> 1) * 16 + swz / 64; C = (st & 1) * 32 + (swz % 64) / 2; }
__host__ __device__ __forceinline__ int perm32(int rho) { const int n = rho >> 4, i = rho & 15; return 8 * (i >> 2) + 4 * n + (i & 3); }

struct Unit { int pm, pn; };
struct Gemm { const bf16_t* A; const bf16_t* Bt; int M, N, K, lda, ldb; };

struct StaticOrder {
    int nM, nN, nwg, G, c;
    __host__ __device__ void init(int M, int N, int G_, int c_) { nM = M / BM; nN = N / BM; nwg = nM * nN; G = G_; c = c_; }
    __host__ __device__ bool next(int i, Unit& u) const {
        const long L = (long)i * G + c; if (L >= nwg) return false;
        int wgid = (int)L; { const int q = nwg / NXCD, r = nwg % NXCD, xcd = wgid % NXCD, off = wgid / NXCD; wgid = (xcd < r ? xcd * (q + 1) : r * (q + 1) + (xcd - r) * q) + off; }
        const int nig = WGM * nN, gid = wgid / nig, fm = gid * WGM, gsz = (nM - fm) < WGM ? (nM - fm) : WGM;
        u.pm = fm + ((wgid % nig) % gsz); u.pn = (wgid % nig) / gsz; return true;
    }
    __device__ __forceinline__ void a_ready(const Unit&) const {}
    __device__ __forceinline__ void done(const Unit&) const {}
};
typedef __bf16 bf16x2_t __attribute__((ext_vector_type(2)));
typedef float f32x2_t __attribute__((ext_vector_type(2)));
__device__ __forceinline__ unsigned cvt_pk_bf16(float lo, float hi) { const f32x2_t v = {lo, hi}; const bf16x2_t b = __builtin_convertvector(v, bf16x2_t); return __builtin_bit_cast(unsigned, b); }

template <class Epi, class Sched, bool ALIGN_EPI = false, bool SP2 = false>
__device__ __forceinline__ void gemm_phase(PG8_LAS unsigned char* lds, const Gemm g, const Sched& S, const Epi& E) {
    const int tid = threadIdx.x, wid = __builtin_amdgcn_readfirstlane(tid >> 6), lane = tid & 63, wr = wid >> 2, wc = wid & 3, fr = lane & 15, fq = lane >> 4;
    const int K = g.K, nt = K / BK;
    unsigned voffA[2], voffB[2];
#pragma unroll
    for (int i = 0; i < 2; ++i) { int R, C; stage_rc(tid * 16 + i * 8192, R, C); const int Rb = Epi::PERM ? ((R & ~31) + perm32(R & 31)) : R;
        voffA[i] = (unsigned)(R * g.lda + C) * 2u; voffB[i] = (unsigned)(Rb * g.ldb + C) * 2u; }
    const size_t kstep = (size_t)(BK * 2);
    const size_t hstepA = (size_t)HALF * g.lda * 2, hstepB = (size_t)HALF * g.ldb * 2;
    const size_t tstepA = 2 * hstepA, tstepB = 2 * hstepB;
    const unsigned ldsw = (unsigned)wid * 1024u;
    const int aoff = lds_byte(wr * 64 + fr, fq * 8), boff = lds_byte(wc * 32 + fr, fq * 8);
#define PG8_SA(b, h) (((b) * 2 + (h)) * HTB)
#define PG8_SB(b, h) ((4 + (b) * 2 + (h)) * HTB)
#define PG8_STAGE(bufoff, gbase, voff) do { _Pragma("unroll") for (int _i = 0; _i < 2; ++_i) \
        __builtin_amdgcn_global_load_lds((const unsigned*)((const char*)(gbase) + (voff)[_i]), (PG8_LAS unsigned*)(lds + (bufoff) + ldsw + _i * 8192), 16, 0, 0); } while (0)
#define PG8_LDA(dst, b, h) do { _Pragma("unroll") for (int m = 0; m < 4; ++m) _Pragma("unroll") for (int k = 0; k < 2; ++k) dst[m][k] = *(const PG8_LAS bf16x8*)(lds + PG8_SA(b, h) + aoff + m * 2048 + k * 1024); } while (0)
#define PG8_LDB(dst, b, h) do { _Pragma("unroll") for (int n = 0; n < 2; ++n) _Pragma("unroll") for (int k = 0; k < 2; ++k) dst[n][k] = *(const PG8_LAS bf16x8*)(lds + PG8_SB(b, h) + boff + n * 2048 + k * 1024); } while (0)
#define PG8_MMA(ai, bj, At, Bt) do { __builtin_amdgcn_s_setprio(1); _Pragma("unroll") for (int m = 0; m < 4; ++m) _Pragma("unroll") for (int n = 0; n < 2; ++n) _Pragma("unroll") for (int k = 0; k < 2; ++k) \
        acc[ai][bj][m][n] = __builtin_amdgcn_mfma_f32_16x16x32_bf16(Bt[n][k], At[m][k], acc[ai][bj][m][n], 0, 0, 0); __builtin_amdgcn_s_setprio(0); } while (0)
#define PG8_WAIT_V(n) asm volatile("s_waitcnt vmcnt(" #n ")" ::: "memory")
#define PG8_WAIT_L(n) asm volatile("s_waitcnt lgkmcnt(" #n ")" ::: "memory")
#define PG8_BAR __builtin_amdgcn_s_barrier()
#define PG8_SCHED __builtin_amdgcn_sched_barrier(0)
    Unit cur, nxt; int ui = 0;
    if (!S.next(0, cur)) return;
    f32x4 acc[2][2][4][2];
#pragma unroll
    for (int a = 0; a < 2; ++a)
#pragma unroll
        for (int b = 0; b < 2; ++b)
#pragma unroll
            for (int m = 0; m < 4; ++m)
#pragma unroll
                for (int n = 0; n < 2; ++n) acc[a][b][m][n] = (f32x4){0.f, 0.f, 0.f, 0.f};
    bf16x8 At[4][2], B0[2][2], B1[2][2];
    const char* cA = (const char*)g.A + (size_t)cur.pm * tstepA; const char* cB = (const char*)g.Bt + (size_t)cur.pn * tstepB;
    S.a_ready(cur);
    if constexpr (SP2) {
        PG8_STAGE(PG8_SB(0, 0), cB, voffB); PG8_STAGE(PG8_SB(0, 1), cB + hstepB, voffB); PG8_STAGE(PG8_SA(0, 0), cA, voffA); PG8_STAGE(PG8_SA(0, 1), cA + hstepA, voffA);
        if (wr == 1) PG8_BAR;
        PG8_WAIT_V(2); PG8_BAR;
        PG8_STAGE(PG8_SB(1, 0), cB + kstep, voffB); PG8_STAGE(PG8_SA(1, 0), cA + kstep, voffA); PG8_STAGE(PG8_SB(1, 1), cB + hstepB + kstep, voffB);
        PG8_WAIT_V(6); PG8_BAR;
    } else {
        PG8_STAGE(PG8_SB(0, 0), cB, voffB); PG8_STAGE(PG8_SA(0, 0), cA, voffA); PG8_STAGE(PG8_SB(0, 1), cB + hstepB, voffB); PG8_STAGE(PG8_SA(0, 1), cA + hstepA, voffA);
        if (wr == 1) PG8_BAR;
        PG8_WAIT_V(4); PG8_BAR;
        PG8_STAGE(PG8_SB(1, 0), cB + kstep, voffB); PG8_STAGE(PG8_SA(1, 0), cA + kstep, voffA); PG8_STAGE(PG8_SB(1, 1), cB + hstepB + kstep, voffB);
        PG8_WAIT_V(6); PG8_BAR;
    }
    for (;;) {
        const bool has_next = S.next(ui + 1, nxt);
        const char* nA = has_next ? (const char*)g.A + (size_t)nxt.pm * tstepA : cA; const char* nB = has_next ? (const char*)g.Bt + (size_t)nxt.pn * tstepB : cB;
        for (int t = 0; t < nt; t += 2) {
            const bool last = (t == nt - 2);
            const char* a1 = cA + (size_t)(t + 1) * kstep;
            const char* a2 = last ? nA : cA + (size_t)(t + 2) * kstep; const char* b2 = last ? nB : cB + (size_t)(t + 2) * kstep;
            const char* a3 = a2 + kstep; const char* b3 = b2 + kstep;
            if (last && has_next) S.a_ready(nxt);
            if constexpr (SP2) {
            PG8_LDB(B0, 0, 0); PG8_LDB(B1, 0, 1); PG8_SCHED; PG8_LDA(At, 0, 0); PG8_STAGE(PG8_SA(1, 1), a1 + hstepA, voffA);
            PG8_WAIT_V(8); PG8_WAIT_L(0); PG8_BAR; PG8_MMA(0, 0, At, B0); PG8_MMA(0, 1, At, B1); PG8_BAR; PG8_SCHED;
            PG8_LDA(At, 0, 1); PG8_STAGE(PG8_SB(0, 0), b2, voffB); PG8_STAGE(PG8_SB(0, 1), b2 + hstepB, voffB); PG8_STAGE(PG8_SA(0, 0), a2, voffA);
            PG8_WAIT_V(8); PG8_WAIT_L(0); PG8_BAR; PG8_MMA(1, 0, At, B0); PG8_MMA(1, 1, At, B1); PG8_BAR; PG8_SCHED;
            PG8_LDB(B0, 1, 0); PG8_LDB(B1, 1, 1); PG8_SCHED; PG8_LDA(At, 1, 0); PG8_STAGE(PG8_SA(0, 1), a2 + hstepA, voffA);
            PG8_WAIT_V(8); PG8_WAIT_L(0); PG8_BAR; PG8_MMA(0, 0, At, B0); PG8_MMA(0, 1, At, B1); PG8_BAR; PG8_SCHED;
            PG8_LDA(At, 1, 1); PG8_STAGE(PG8_SB(1, 0), b3, voffB); PG8_STAGE(PG8_SB(1, 1), b3 + hstepB, voffB); PG8_STAGE(PG8_SA(1, 0), a3, voffA);
            PG8_WAIT_V(8); PG8_WAIT_L(0); PG8_BAR; PG8_MMA(1, 0, At, B0); PG8_MMA(1, 1, At, B1); PG8_BAR; PG8_SCHED;
            } else {
            PG8_LDB(B0, 0, 0); PG8_SCHED; PG8_LDA(At, 0, 0); PG8_STAGE(PG8_SA(1, 1), a1 + hstepA, voffA);
            PG8_WAIT_L(8); PG8_BAR; PG8_WAIT_L(0); PG8_MMA(0, 0, At, B0); PG8_BAR; PG8_SCHED;
            PG8_LDB(B1, 0, 1); PG8_STAGE(PG8_SB(0, 0), b2, voffB);
            PG8_BAR; PG8_WAIT_L(0); PG8_MMA(0, 1, At, B1); PG8_BAR;
            PG8_LDA(At, 0, 1); PG8_STAGE(PG8_SA(0, 0), a2, voffA);
            PG8_BAR; PG8_WAIT_L(0); PG8_MMA(1, 0, At, B0); PG8_BAR; PG8_SCHED;
            PG8_STAGE(PG8_SB(0, 1), b2 + hstepB, voffB);
            PG8_WAIT_V(6); PG8_BAR; PG8_MMA(1, 1, At, B1); PG8_BAR;
            PG8_LDB(B0, 1, 0); PG8_SCHED; PG8_LDA(At, 1, 0); PG8_STAGE(PG8_SA(0, 1), a2 + hstepA, voffA);
            PG8_WAIT_L(8); PG8_BAR; PG8_WAIT_L(0); PG8_MMA(0, 0, At, B0); PG8_BAR; PG8_SCHED;
            PG8_LDB(B1, 1, 1); PG8_STAGE(PG8_SB(1, 0), b3, voffB);
            PG8_BAR; PG8_WAIT_L(0); PG8_MMA(0, 1, At, B1); PG8_BAR;
            PG8_LDA(At, 1, 1); PG8_STAGE(PG8_SA(1, 0), a3, voffA);
            PG8_BAR; PG8_WAIT_L(0); PG8_MMA(1, 0, At, B0); PG8_BAR; PG8_SCHED;
            PG8_STAGE(PG8_SB(1, 1), b3 + hstepB, voffB);
            PG8_WAIT_V(6); PG8_BAR; PG8_MMA(1, 1, At, B1); PG8_BAR;
            }
        }
        if constexpr (ALIGN_EPI) { if (wr == 0) PG8_BAR; }
        if constexpr (!Epi::AFTER_DRAIN) { E(acc, cur, wr, wc, fr, fq); S.done(cur); }
        if (!has_next) break;
#pragma unroll
        for (int a = 0; a < 2; ++a)
#pragma unroll
            for (int b = 0; b < 2; ++b)
#pragma unroll
                for (int m = 0; m < 4; ++m)
#pragma unroll
                    for (int n = 0; n < 2; ++n) acc[a][b][m][n] = (f32x4){0.f, 0.f, 0.f, 0.f};
        cur = nxt; cA = nA; cB = nB; ++ui;
        if constexpr (ALIGN_EPI) { if (wr == 1) PG8_BAR; }
    }
    PG8_WAIT_V(0);
    if constexpr (!ALIGN_EPI) { if (wr == 0) PG8_BAR; }
    PG8_BAR;
    if constexpr (Epi::AFTER_DRAIN) { E.fused(acc, cur, wr, wc, fr, fq, lds, wid, lane); S.done(cur); }
#undef PG8_SA
#undef PG8_SB
#undef PG8_STAGE
#undef PG8_LDA
#undef PG8_LDB
#undef PG8_MMA
#undef PG8_WAIT_V
#undef PG8_WAIT_L
#undef PG8_BAR
#undef PG8_SCHED
}

}

#define LAS __attribute__((address_space(3)))
typedef unsigned short bf16_t;
typedef unsigned u32;
typedef u32 u32x4 __attribute__((ext_vector_type(4)));
typedef float f32x4 __attribute__((ext_vector_type(4)));
typedef short bf16x8 __attribute__((ext_vector_type(8)));
using pg8::Unit;

constexpr int NB = 16, SEQ = 2048, D = 1024, M = NB * SEQ, PIN = 8704, RGW = 1280, NH = 16, HD = 80, K2 = D + RGW  ;
constexpr float EPS = 1e-6f;
constexpr int NTHR = 512, NWAVES = 8;
constexpr int LDS_BYTES = 140 * 1024;
constexpr size_t MiB = 1024 * 1024;
constexpr size_t WS_WIN = 0, WS_W2 = 18 * MiB, WS_WOUT = 23 * MiB, WS_MOD = 25 * MiB, WS_BAR = 25 * MiB + 512 * 1024  , WS_RSS = 26 * MiB;
constexpr size_t WS_HN = 28 * MiB  , WS_CV = 92 * MiB  , WS_RV = 156 * MiB  , WS_A2 = 236 * MiB  ,
                 WS_GR = 380 * MiB  , WS_GB = 444 * MiB  , WS_END = 508 * MiB;

struct P {
    const float *x, *c, *w_ada, *b_ada, *g_norm, *w_in, *sc_conv_w, *sc_conv_b, *sc_w_out, *rg_conv_w, *rg_conv_b, *rg_w_a, *rg_b_a, *rg_w_x, *rg_b_x, *rg_lambda, *rg_w_out, *b_merge, *w_out, *g_final;
    float* out; unsigned char* ws; int ph_lo, ph_hi;
};

__device__ __forceinline__ u32 pk2(float lo, float hi) { return pg8::cvt_pk_bf16(lo, hi); }
__device__ __forceinline__ float bf_lo(u32 w) { return __uint_as_float(w << 16); }
__device__ __forceinline__ float bf_hi(u32 w) { return __uint_as_float(w & 0xffff0000u); }
__device__ __forceinline__ float sigm(float v) { return __builtin_amdgcn_rcpf(1.f + __expf(-v)); }
__device__ __forceinline__ float silu(float v) { return v * sigm(v); }
__device__ __forceinline__ float wave_sum(float v) {
#pragma unroll
    for (int o = 1; o < 64; o <<= 1) v += __shfl_xor(v, o);
    return v;
}
#define LDS_WAIT() asm volatile("s_waitcnt lgkmcnt(0)" ::: "memory")

#define XB_TMO      128
#define XB_XCNT(j)  (256  + 64 * (j))
#define XB_XSUB(j)  (1280 + 64 * (j))
#define XB_XGEN(j)  (2304 + 64 * (j))
#define XB_TOP      3328
#define XB_TOPGEN   3392
#define XCD_BAR_WORDS 3456
#define XB_SPIN_CAP (1u << 18)
__device__ __forceinline__ unsigned xb_ld(unsigned* q)              { return __hip_atomic_load(q, __ATOMIC_RELAXED, __HIP_MEMORY_SCOPE_AGENT); }
__device__ __forceinline__ unsigned xb_add(unsigned* q, unsigned v) { return __hip_atomic_fetch_add(q, v, __ATOMIC_RELAXED, __HIP_MEMORY_SCOPE_AGENT); }
__device__ __forceinline__ unsigned xb_xcc_id() { return (unsigned)__builtin_amdgcn_s_getreg((3 << 11) | 20) & 0xFu; }
#define XB_SPIN(cond, bar) do { unsigned _sp = 0; while (cond) { __builtin_amdgcn_s_sleep(1); \
    if ((++_sp & 255u) == 0u) { if (xb_ld(&(bar)[XB_TMO])) break; if (_sp > XB_SPIN_CAP) { atomicAdd(&(bar)[XB_TMO], 1u); break; } } } } while (0)
struct XcdBarrier { unsigned* bar; unsigned x; volatile LAS unsigned* st; };
__device__ __forceinline__ XcdBarrier xcd_barrier_post(unsigned* bar, volatile LAS unsigned* st) {
    XcdBarrier b; b.bar = bar; b.x = xb_xcc_id(); b.st = st;
    if (threadIdx.x == 0) (void)xb_add(&bar[XB_XCNT(b.x)], 1u);
    return b;
}
__device__ __forceinline__ void xcd_barrier_complete(unsigned* bar, unsigned x, unsigned& nloc, unsigned& nx) {
    const unsigned G = gridDim.x * gridDim.y * gridDim.z;
    unsigned sum, cnt, mine, sp = 0u;
    for (;;) {
        sum = 0u; cnt = 0u; mine = 0u;
#pragma unroll
        for (unsigned j = 0; j < 16; ++j) { const unsigned c = xb_ld(&bar[XB_XCNT(j)]); sum += c; cnt += (c > 0u) ? 1u : 0u; mine = (j == x) ? c : mine; }
        if (sum == G) break;
        __builtin_amdgcn_s_sleep(1);
        if ((++sp & 255u) == 0u) { if (xb_ld(&bar[XB_TMO])) break; if (sp > XB_SPIN_CAP) { atomicAdd(&bar[XB_TMO], 1u); break; } }
    }
    nloc = mine > 0u ? mine : 1u; nx = cnt > 0u ? cnt : 1u;
}
__device__ __forceinline__ void xcd_barrier(const XcdBarrier& b) {
    asm volatile("s_waitcnt vmcnt(0)" ::: "memory");
    __syncthreads();
    if (threadIdx.x == 0) {
        unsigned* bar = b.bar;
        __builtin_amdgcn_s_waitcnt(0);
        unsigned nloc = b.st[0], nx = b.st[1];
        if (nloc == 0u) { xcd_barrier_complete(bar, b.x, nloc, nx); b.st[0] = nloc; b.st[1] = nx; }
        const unsigned old = xb_add(&bar[XB_XSUB(b.x)], 1u);
        const unsigned gen = old / nloc;
        if (old + 1u == (gen + 1u) * nloc) {
            __builtin_amdgcn_fence(__ATOMIC_RELEASE, "agent");
            asm volatile("s_waitcnt vmcnt(0)" ::: "memory");
            const unsigned og = xb_add(&bar[XB_TOP], 1u);
            const unsigned tg = og / nx;
            if (og + 1u == (tg + 1u) * nx) xb_add(&bar[XB_TOPGEN], 1u);
            else XB_SPIN(xb_ld(&bar[XB_TOPGEN]) == tg, bar);
            __builtin_amdgcn_fence(__ATOMIC_ACQUIRE, "agent");
            xb_add(&bar[XB_XGEN(b.x)], 1u);
            asm volatile("s_waitcnt vmcnt(0)" ::: "memory");
        } else {
            XB_SPIN(xb_ld(&bar[XB_XGEN(b.x)]) == gen, bar);
            __builtin_amdgcn_fence(__ATOMIC_ACQUIRE, "agent");
            asm volatile("s_waitcnt vmcnt(0)" ::: "memory");
        }
    }
    __syncthreads();
}

struct EpiIn {
    static constexpr bool PERM = true, AFTER_DRAIN = false;
    bf16_t *CV, *A2, *RV, *GR, *GB; const float* bm;
    __device__ __forceinline__ void operator()(const f32x4 (&acc)[2][2][4][2], const Unit& u, int wr, int wc, int fr, int fq) const {
        const int row0 = u.pm * 256 + wr * 64 + fr, jj = wc * 32 + 8 * fq, pn = u.pn;
        if (pn < 8) {
            const int col = pn * 128 + jj;
#pragma unroll
            for (int ai = 0; ai < 2; ++ai)
#pragma unroll
                for (int m = 0; m < 4; ++m) { const size_t r = (size_t)(row0 + ai * 128 + m * 16);
                    const f32x4 X0 = acc[ai][0][m][0], X1 = acc[ai][0][m][1], Y0 = acc[ai][1][m][0], Y1 = acc[ai][1][m][1];
                    u32x4 w; w.x = pk2(X0[0] * Y0[0], X0[1] * Y0[1]); w.y = pk2(X0[2] * Y0[2], X0[3] * Y0[3]); w.z = pk2(X1[0] * Y1[0], X1[1] * Y1[1]); w.w = pk2(X1[2] * Y1[2], X1[3] * Y1[3]);
                    *(u32x4*)(CV + r * D + col) = w; }
        } else if (pn < 16) {
            const int col = (pn - 8) * 128 + jj;
#pragma unroll
            for (int ai = 0; ai < 2; ++ai)
#pragma unroll
                for (int m = 0; m < 4; ++m) { const size_t r = (size_t)(row0 + ai * 128 + m * 16);
                    const f32x4 X0 = acc[ai][0][m][0], X1 = acc[ai][0][m][1], Y0 = acc[ai][1][m][0], Y1 = acc[ai][1][m][1];
                    u32x4 w; w.x = pk2(X0[0] * silu(Y0[0]), X0[1] * silu(Y0[1])); w.y = pk2(X0[2] * silu(Y0[2]), X0[3] * silu(Y0[3]));
                    w.z = pk2(X1[0] * silu(Y1[0]), X1[1] * silu(Y1[1])); w.w = pk2(X1[2] * silu(Y1[2]), X1[3] * silu(Y1[3]));
                    *(u32x4*)(A2 + r * K2 + col) = w; }
        } else if (pn < 26) {
            const int col = (pn - 16) * 128 + jj;
#pragma unroll
            for (int ai = 0; ai < 2; ++ai)
#pragma unroll
                for (int m = 0; m < 4; ++m) { const size_t r = (size_t)(row0 + ai * 128 + m * 16);
                    const f32x4 X0 = acc[ai][0][m][0], X1 = acc[ai][0][m][1], Y0 = acc[ai][1][m][0], Y1 = acc[ai][1][m][1];
                    u32x4 w; w.x = pk2(X0[0], X0[1]); w.y = pk2(X0[2], X0[3]); w.z = pk2(X1[0], X1[1]); w.w = pk2(X1[2], X1[3]);
                    *(u32x4*)(RV + r * RGW + col) = w;
                    u32x4 s; s.x = pk2(silu(Y0[0]), silu(Y0[1])); s.y = pk2(silu(Y0[2]), silu(Y0[3])); s.z = pk2(silu(Y1[0]), silu(Y1[1])); s.w = pk2(silu(Y1[2]), silu(Y1[3]));
                    *(u32x4*)(A2 + r * K2 + D + col) = s; }
        } else {
            const int col = (pn - 26) * 128 + jj;
            const f32x4 ba0 = *(const f32x4*)(bm + col), ba1 = *(const f32x4*)(bm + col + 4), bb0 = *(const f32x4*)(bm + D + col), bb1 = *(const f32x4*)(bm + D + col + 4);
#pragma unroll
            for (int ai = 0; ai < 2; ++ai)
#pragma unroll
                for (int m = 0; m < 4; ++m) { const size_t r = (size_t)(row0 + ai * 128 + m * 16);
                    const f32x4 X0 = acc[ai][0][m][0] + ba0, X1 = acc[ai][0][m][1] + ba1, Y0 = acc[ai][1][m][0] + bb0, Y1 = acc[ai][1][m][1] + bb1;
                    float gr[8], gb[8];
#pragma unroll
                    for (int e = 0; e < 4; ++e) { const float ea0 = 1.f + __expf(-X0[e]), eb0 = 1.f + __expf(-Y0[e]), ea1 = 1.f + __expf(-X1[e]), eb1 = 1.f + __expf(-Y1[e]);
                        gb[e] = __builtin_amdgcn_rcpf(eb0); gr[e] = __builtin_amdgcn_rcpf(ea0); gb[4 + e] = __builtin_amdgcn_rcpf(eb1); gr[4 + e] = __builtin_amdgcn_rcpf(ea1); }
                    u32x4 w; w.x = pk2(gr[0], gr[1]); w.y = pk2(gr[2], gr[3]); w.z = pk2(gr[4], gr[5]); w.w = pk2(gr[6], gr[7]);
                    *(u32x4*)(GR + r * D + col) = w;
                    u32x4 s; s.x = pk2(gb[0], gb[1]); s.y = pk2(gb[2], gb[3]); s.z = pk2(gb[4], gb[5]); s.w = pk2(gb[6], gb[7]);
                    *(u32x4*)(GB + r * D + col) = s; }
        }
    }
};
template <bool ADD> struct EpiMerge {
    static constexpr bool PERM = true, AFTER_DRAIN = false;
    const bf16_t* GG; bf16_t* MRG;
    __device__ __forceinline__ void operator()(const f32x4 (&acc)[2][2][4][2], const Unit& u, int wr, int wc, int fr, int fq) const {
        const int row0 = u.pm * 256 + wr * 64 + fr, col0 = u.pn * 256 + wc * 32 + 8 * fq;
#pragma unroll
        for (int ai = 0; ai < 2; ++ai)
#pragma unroll
            for (int m = 0; m < 4; ++m) { const size_t r = (size_t)(row0 + ai * 128 + m * 16);
#pragma unroll
                for (int bj = 0; bj < 2; ++bj) { const u32x4 g = *(const u32x4*)(GG + r * D + col0 + bj * 128); const f32x4 v0 = acc[ai][bj][m][0], v1 = acc[ai][bj][m][1];
                    float o[8] = {v0[0] * bf_lo(g.x), v0[1] * bf_hi(g.x), v0[2] * bf_lo(g.y), v0[3] * bf_hi(g.y), v1[0] * bf_lo(g.z), v1[1] * bf_hi(g.z), v1[2] * bf_lo(g.w), v1[3] * bf_hi(g.w)};
                    if (ADD) { const u32x4 t = *(const u32x4*)(MRG + r * D + col0 + bj * 128);
                        o[0] += bf_lo(t.x); o[1] += bf_hi(t.x); o[2] += bf_lo(t.y); o[3] += bf_hi(t.y); o[4] += bf_lo(t.z); o[5] += bf_hi(t.z); o[6] += bf_lo(t.w); o[7] += bf_hi(t.w); }
                    u32x4 w; w.x = pk2(o[0], o[1]); w.y = pk2(o[2], o[3]); w.z = pk2(o[4], o[5]); w.w = pk2(o[6], o[7]);
                    *(u32x4*)(MRG + r * D + col0 + bj * 128) = w; } }
    }
};
struct EpiOut {
    static constexpr bool PERM = false, AFTER_DRAIN = false;
    const float *x, *mod; float *out, *rss;
    __device__ __forceinline__ void operator()(const f32x4 (&acc)[2][2][4][2], const Unit& u, int wr, int wc, int fr, int fq) const {
        const int row0 = u.pm * 256 + wr * 64 + fr, col0 = u.pn * 256 + wc * 32 + 4 * fq, b = u.pm >> 3;
        const float* gate = mod + (size_t)b * 3 * D + 2 * D + col0;
        f32x4 gv[2][2];
#pragma unroll
        for (int bj = 0; bj < 2; ++bj)
#pragma unroll
            for (int n = 0; n < 2; ++n) gv[bj][n] = *(const f32x4*)(gate + bj * 128 + n * 16);
#pragma unroll
        for (int ai = 0; ai < 2; ++ai)
#pragma unroll
            for (int m = 0; m < 4; ++m) { const size_t r = (size_t)(row0 + ai * 128 + m * 16); float ss = 0.f;
#pragma unroll
                for (int bj = 0; bj < 2; ++bj)
#pragma unroll
                    for (int n = 0; n < 2; ++n) { const f32x4 xv = *(const f32x4*)(x + r * D + col0 + bj * 128 + n * 16); const f32x4 o = xv + gv[bj][n] * acc[ai][bj][m][n];
                        *(f32x4*)(out + r * D + col0 + bj * 128 + n * 16) = o; ss += (o[0] * o[0] + o[1] * o[1]) + (o[2] * o[2] + o[3] * o[3]); }
                ss += __shfl_xor(ss, 16); ss += __shfl_xor(ss, 32);
                if (fq == 0) rss[(size_t)(u.pn * 4 + wc) * M + r] = ss; }
    }
};

__device__ __forceinline__ void tr_item(const float* W, int N, int k0, int n0, bf16_t* WT, int ldk, int drow0, int dk0, LAS float* scr, int lane) {
#pragma unroll 8
    for (int i = 0; i < 32; ++i) { const int kk = 2 * i + (lane >> 5); scr[kk * 33 + (lane & 31)] = W[(size_t)(k0 + kk) * N + n0 + (lane & 31)]; }
    LDS_WAIT();
    const int c = lane & 7;
#pragma unroll
    for (int j = 0; j < 4; ++j) { const int n = (lane >> 3) + 8 * j; const LAS float* s = scr + (8 * c) * 33 + n;
        u32x4 o; o.x = pk2(s[0 * 33], s[1 * 33]); o.y = pk2(s[2 * 33], s[3 * 33]); o.z = pk2(s[4 * 33], s[5 * 33]); o.w = pk2(s[6 * 33], s[7 * 33]);
        *(u32x4*)(WT + (size_t)(drow0 + n) * ldk + dk0 + 8 * c) = o; }
    LDS_WAIT();
}
__device__ __forceinline__ int src_col_of_tile(int pn, int half) {
    if (pn < 8) return (half ? 2048 : 1024) + pn * 128;
    if (pn < 16) return (half ? 3072 : 0) + (pn - 8) * 128;
    if (pn < 26) return (half ? 5376 : 4096) + (pn - 16) * 128;
    return (half ? 7680 : 6656) + (pn - 26) * 128;
}
__device__ __forceinline__ void phase_prep(const P& p, LAS unsigned char* lds) {
    const int tid = threadIdx.x, lane = tid & 63, wave = tid >> 6, G = gridDim.x;
    bf16_t* Win_t = (bf16_t*)(p.ws + WS_WIN); bf16_t* W2_t = (bf16_t*)(p.ws + WS_W2); bf16_t* Wout_t = (bf16_t*)(p.ws + WS_WOUT); float* mod = (float*)(p.ws + WS_MOD);
    for (int it = blockIdx.x; it < 48; it += G) {
        LAS float* cs = (LAS float*)lds;
        LAS float* red = (LAS float*)(lds + 65536);
        for (int i = tid; i < NB * D; i += NTHR) cs[i] = silu(p.c[i]);
        __syncthreads();
        const int col = it * 64 + lane, kp = wave;
        float a[16];
#pragma unroll
        for (int b = 0; b < 16; ++b) a[b] = 0.f;
        for (int k = kp * 128; k < kp * 128 + 128; k += 4) {
            const float w0 = p.w_ada[(size_t)(k + 0) * 3 * D + col], w1 = p.w_ada[(size_t)(k + 1) * 3 * D + col], w2 = p.w_ada[(size_t)(k + 2) * 3 * D + col], w3 = p.w_ada[(size_t)(k + 3) * 3 * D + col];
#pragma unroll
            for (int b = 0; b < 16; ++b) { const f32x4 cv = *(const LAS f32x4*)(cs + b * D + k); a[b] += cv[0] * w0 + cv[1] * w1 + cv[2] * w2 + cv[3] * w3; }
        }
#pragma unroll
        for (int b = 0; b < 16; ++b) red[(kp * 16 + b) * 64 + lane] = a[b];
        __syncthreads();
        for (int o = tid; o < 16 * 64; o += NTHR) { const int b = o >> 6, cc = o & 63; float s = p.b_ada[it * 64 + cc];
#pragma unroll
            for (int q = 0; q < 8; ++q) s += red[(q * 16 + b) * 64 + cc];
            mod[b * 3 * D + it * 64 + cc] = s; }
        __syncthreads();
    }
    LAS float* scr = (LAS float*)(lds + wave * 16384);
    const int gw = blockIdx.x * NWAVES + wave, NGW = G * NWAVES;
    constexpr int I_IN = 16 * 272, I_A = 16 * 32, I_B = 20 * 32, I_O = 16 * 32, NIT = I_IN + I_A + I_B + I_O;
    for (int it = gw; it < NIT; it += NGW) {
        int r = it;
        if (r < I_IN) { const int kb = r / 272, nbp = r % 272, pn = nbp >> 3, half = (nbp >> 2) & 1, sub = nbp & 3;
            tr_item(p.w_in, PIN, kb * 64, src_col_of_tile(pn, half) + sub * 32, Win_t, D, nbp * 32, kb * 64, scr, lane); continue; }
        r -= I_IN;
        if (r < I_A) { const int kb = r >> 5, nb = r & 31; tr_item(p.sc_w_out, D, kb * 64, nb * 32, W2_t, K2, nb * 32, kb * 64, scr, lane); continue; }
        r -= I_A;
        if (r < I_B) { const int kb = r >> 5, nb = r & 31; tr_item(p.rg_w_out, D, kb * 64, nb * 32, W2_t, K2, nb * 32, D + kb * 64, scr, lane); continue; }
        r -= I_B;
        { const int kb = r >> 5, nb = r & 31; tr_item(p.w_out, D, kb * 64, nb * 32, Wout_t, D, nb * 32, kb * 64, scr, lane); }
    }
    __syncthreads();
}

__device__ __forceinline__ void phase_h(const P& p) {
    const int tid = threadIdx.x, lane = tid & 63, wave = tid >> 6, G = gridDim.x;
    const float* mod = (const float*)(p.ws + WS_MOD); bf16_t* HN = (bf16_t*)(p.ws + WS_HN);
    for (int r0 = (blockIdx.x * NWAVES + wave) * 16; r0 < M; r0 += G * NWAVES * 16) {
        const int b = r0 >> 11;
        f32x4 gs[4], sh[4];
#pragma unroll
        for (int j = 0; j < 4; ++j) { const int c = 4 * lane + 256 * j; const f32x4 g = *(const f32x4*)(p.g_norm + c), sc = *(const f32x4*)(mod + b * 3 * D + D + c);
            gs[j] = g * (sc + 1.0f); sh[j] = *(const f32x4*)(mod + b * 3 * D + c); }
        for (int i = 0; i < 16; ++i) { const size_t r = (size_t)(r0 + i);
            f32x4 v[4]; float s = 0.f;
#pragma unroll
            for (int j = 0; j < 4; ++j) { v[j] = *(const f32x4*)(p.x + r * D + 4 * lane + 256 * j); s += (v[j][0] * v[j][0] + v[j][1] * v[j][1]) + (v[j][2] * v[j][2] + v[j][3] * v[j][3]); }
            const float rstd = 1.0f / sqrtf(wave_sum(s) * (1.0f / D) + EPS);
#pragma unroll
            for (int j = 0; j < 4; ++j) { const f32x4 o = v[j] * rstd * gs[j] + sh[j];
                unsigned long long w = (unsigned long long)pk2(o[0], o[1]) | ((unsigned long long)pk2(o[2], o[3]) << 32);
                *(unsigned long long*)(HN + r * D + 4 * lane + 256 * j) = w; }
        }
    }
}

__device__ __forceinline__ void phase_convgate(const P& p) {
    const int tid = threadIdx.x, G = gridDim.x;
    const bf16_t* CV = (const bf16_t*)(p.ws + WS_CV); bf16_t* A2 = (bf16_t*)(p.ws + WS_A2);
    const int c0 = (tid & 127) * 8, run = tid >> 7;
    float w0[8], w1[8], w2[8], cb[8];
#pragma unroll
    for (int e = 0; e < 8; ++e) { w0[e] = p.sc_conv_w[c0 + e]; w1[e] = p.sc_conv_w[D + c0 + e]; w2[e] = p.sc_conv_w[2 * D + c0 + e]; cb[e] = p.sc_conv_b[c0 + e]; }
    for (int it = blockIdx.x; it < M / 128; it += G) {
        const size_t T0 = (size_t)it * 128 + run * 32;
        float c2[8], c1[8];
        if ((T0 & (SEQ - 1)) == 0) {
#pragma unroll
            for (int e = 0; e < 8; ++e) { c2[e] = 0.f; c1[e] = 0.f; }
        } else {
            const u32x4 a = *(const u32x4*)(CV + (T0 - 2) * D + c0), bq = *(const u32x4*)(CV + (T0 - 1) * D + c0);
            c2[0] = bf_lo(a.x); c2[1] = bf_hi(a.x); c2[2] = bf_lo(a.y); c2[3] = bf_hi(a.y); c2[4] = bf_lo(a.z); c2[5] = bf_hi(a.z); c2[6] = bf_lo(a.w); c2[7] = bf_hi(a.w);
            c1[0] = bf_lo(bq.x); c1[1] = bf_hi(bq.x); c1[2] = bf_lo(bq.y); c1[3] = bf_hi(bq.y); c1[4] = bf_lo(bq.z); c1[5] = bf_hi(bq.z); c1[6] = bf_lo(bq.w); c1[7] = bf_hi(bq.w);
        }
#pragma unroll 4
        for (int t = 0; t < 32; ++t) {
            const u32x4 cq = *(const u32x4*)(CV + (T0 + t) * D + c0); const u32x4 bg = *(const u32x4*)(A2 + (T0 + t) * K2 + c0);
            float cu[8], bv[8], o[8];
            cu[0] = bf_lo(cq.x); cu[1] = bf_hi(cq.x); cu[2] = bf_lo(cq.y); cu[3] = bf_hi(cq.y); cu[4] = bf_lo(cq.z); cu[5] = bf_hi(cq.z); cu[6] = bf_lo(cq.w); cu[7] = bf_hi(cq.w);
            bv[0] = bf_lo(bg.x); bv[1] = bf_hi(bg.x); bv[2] = bf_lo(bg.y); bv[3] = bf_hi(bg.y); bv[4] = bf_lo(bg.z); bv[5] = bf_hi(bg.z); bv[6] = bf_lo(bg.w); bv[7] = bf_hi(bg.w);
#pragma unroll
            for (int e = 0; e < 8; ++e) { o[e] = bv[e] * (cb[e] + w0[e] * c2[e] + w1[e] * c1[e] + w2[e] * cu[e]); c2[e] = c1[e]; c1[e] = cu[e]; }
            u32x4 w; w.x = pk2(o[0], o[1]); w.y = pk2(o[2], o[3]); w.z = pk2(o[4], o[5]); w.w = pk2(o[6], o[7]);
            *(u32x4*)(A2 + (T0 + t) * K2 + c0) = w;
        }
    }
}

constexpr int RG_LD = 104;
constexpr int RG_TT = 128;
constexpr int RG_YLD = 84;
constexpr int RG_WT = 0, RG_PRM = 33280, RG_VB = 36864, RG_VBSZ = RG_TT * RG_LD * 2, RG_YB = RG_VB + 2 * RG_VBSZ, RG_COMP = RG_YB + RG_TT * RG_YLD * 4, RG_HST = RG_COMP + 8 * 80 * 2 * 4, RG_END = RG_HST + 2 * 80 * 4;
constexpr float LOG2E = 1.4426950408889634f;
__device__ __forceinline__ void phase_rglru(const P& p, LAS unsigned char* lds) {
    const int tid = threadIdx.x, lane = tid & 63, wave = tid >> 6, fr = lane & 15, fq = lane >> 4, G = gridDim.x;
    const bf16_t* RV = (const bf16_t*)(p.ws + WS_RV); bf16_t* A2 = (bf16_t*)(p.ws + WS_A2);
    LAS bf16_t* WT = (LAS bf16_t*)(lds + RG_WT);
    LAS float* PRM = (LAS float*)(lds + RG_PRM);
    LAS float* YB = (LAS float*)(lds + RG_YB);
    LAS float* COMP = (LAS float*)(lds + RG_COMP);
    LAS float* HST = (LAS float*)(lds + RG_HST);
    int pt[3], pc[3];
#pragma unroll
    for (int i = 0; i < 3; ++i) { const int pidx = tid + NTHR * i; pt[i] = pidx / 10; pc[i] = pidx - pt[i] * 10; }
    const bool has2 = tid < RG_TT * 10 - 2 * NTHR;
    for (int item = blockIdx.x; item < NB * NH; item += G) {
        const int b = item >> 4, h = item & 15;
        for (int idx = tid; idx < 2 * 6400; idx += NTHR) { const int g = idx / 6400, rem = idx - g * 6400, d = rem / 80, e = rem - d * 80;
            const float v = (g ? p.rg_w_x : p.rg_w_a)[h * 6400 + rem] * (-LOG2E); WT[(g * 80 + e) * RG_LD + d] = (bf16_t)(pk2(v, 0.f) & 0xffffu); }
        for (int idx = tid; idx < 160 * 16; idx += NTHR) WT[(idx >> 4) * RG_LD + 80 + (idx & 15)] = 0;
        for (int idx = tid; idx < 2 * RG_TT * 16; idx += NTHR) ((LAS bf16_t*)(lds + RG_VB))[(idx >> 4) * RG_LD + 80 + (idx & 15)] = 0;
        if (tid < 80) { const int ch = h * 80 + tid;
#pragma unroll
            for (int k = 0; k < 4; ++k) PRM[k * 80 + tid] = p.rg_conv_w[k * RGW + ch];
            PRM[4 * 80 + tid] = p.rg_conv_b[ch]; PRM[5 * 80 + tid] = -LOG2E * p.rg_b_a[ch]; PRM[6 * 80 + tid] = -LOG2E * p.rg_b_x[ch];
            PRM[7 * 80 + tid] = 8.0f * LOG2E * log1pf(expf(-p.rg_lambda[ch])); HST[tid] = 0.f; }
        __syncthreads();
        const bf16_t* const rvb = RV + (size_t)b * SEQ * RGW + h * 80;
        bf16_t* const a2b = A2 + (size_t)b * SEQ * K2 + D + h * 80;
        u32x4 rv[3][4], sgn[3], sgc[3];
        const u32x4 z4 = {0u, 0u, 0u, 0u};
#define RG_LOAD(TT) do { _Pragma("unroll") for (int i = 0; i < 3; ++i) { if (i < 2 || has2) { const int s = (TT) * RG_TT + pt[i]; const bf16_t* src = rvb + (size_t)s * RGW + pc[i] * 8; \
            rv[i][3] = *(const u32x4*)src; rv[i][2] = s >= 1 ? *(const u32x4*)(src - RGW) : z4; rv[i][1] = s >= 2 ? *(const u32x4*)(src - 2 * RGW) : z4; rv[i][0] = s >= 3 ? *(const u32x4*)(src - 3 * RGW) : z4; \
            sgn[i] = *(const u32x4*)(a2b + (size_t)s * K2 + pc[i] * 8); } } } while (0)
#define RG_CONV(VBUF) do { _Pragma("unroll") for (int i = 0; i < 3; ++i) { if (i < 2 || has2) { const int c = pc[i]; float o[8]; \
            _Pragma("unroll") for (int hh = 0; hh < 2; ++hh) { \
                const f32x4 k0 = *(const LAS f32x4*)(PRM + 0 * 80 + c * 8 + 4 * hh), k1 = *(const LAS f32x4*)(PRM + 1 * 80 + c * 8 + 4 * hh), k2 = *(const LAS f32x4*)(PRM + 2 * 80 + c * 8 + 4 * hh), \
                            k3 = *(const LAS f32x4*)(PRM + 3 * 80 + c * 8 + 4 * hh), kb = *(const LAS f32x4*)(PRM + 4 * 80 + c * 8 + 4 * hh); \
                const u32 a0 = hh ? rv[i][0].z : rv[i][0].x, a1 = hh ? rv[i][0].w : rv[i][0].y, b0 = hh ? rv[i][1].z : rv[i][1].x, b1 = hh ? rv[i][1].w : rv[i][1].y, \
                          c0 = hh ? rv[i][2].z : rv[i][2].x, c1 = hh ? rv[i][2].w : rv[i][2].y, d0 = hh ? rv[i][3].z : rv[i][3].x, d1 = hh ? rv[i][3].w : rv[i][3].y; \
                o[4 * hh + 0] = kb[0] + k0[0] * bf_lo(a0) + k1[0] * bf_lo(b0) + k2[0] * bf_lo(c0) + k3[0] * bf_lo(d0); \
                o[4 * hh + 1] = kb[1] + k0[1] * bf_hi(a0) + k1[1] * bf_hi(b0) + k2[1] * bf_hi(c0) + k3[1] * bf_hi(d0); \
                o[4 * hh + 2] = kb[2] + k0[2] * bf_lo(a1) + k1[2] * bf_lo(b1) + k2[2] * bf_lo(c1) + k3[2] * bf_lo(d1); \
                o[4 * hh + 3] = kb[3] + k0[3] * bf_hi(a1) + k1[3] * bf_hi(b1) + k2[3] * bf_hi(c1) + k3[3] * bf_hi(d1); } \
            u32x4 w; w.x = pk2(o[0], o[1]); w.y = pk2(o[2], o[3]); w.z = pk2(o[4], o[5]); w.w = pk2(o[6], o[7]); \
            *(LAS u32x4*)((VBUF) + pt[i] * RG_LD + c * 8) = w; } } } while (0)
        RG_LOAD(0);
        RG_CONV((LAS bf16_t*)(lds + RG_VB));
#pragma unroll
        for (int i = 0; i < 3; ++i) sgc[i] = sgn[i];
        __syncthreads();
#pragma unroll 1
        for (int tt = 0; tt < SEQ / RG_TT; ++tt) {
            LAS bf16_t* const VB = (LAS bf16_t*)(lds + RG_VB + (tt & 1) * RG_VBSZ);
            LAS bf16_t* const VBn = (LAS bf16_t*)(lds + RG_VB + ((tt + 1) & 1) * RG_VBSZ);
            const bool more = tt + 1 < SEQ / RG_TT;
            if (more) RG_LOAD(tt + 1);
            const int t0 = wave * 16;
            float hl[5][4], ca[5][4], Aw[5], Hw[5];
            {
                f32x4 acc[2][5];
#pragma unroll
                for (int n = 0; n < 5; ++n) { const float ba = PRM[5 * 80 + n * 16 + fr], bx = PRM[6 * 80 + n * 16 + fr]; acc[0][n] = (f32x4){ba, ba, ba, ba}; acc[1][n] = (f32x4){bx, bx, bx, bx}; }
#pragma unroll
                for (int ks = 0; ks < 3; ++ks) {
                    const bf16x8 af = *(const LAS bf16x8*)(VB + (t0 + fr) * RG_LD + ks * 32 + fq * 8);
#pragma unroll
                    for (int g = 0; g < 2; ++g)
#pragma unroll
                        for (int n = 0; n < 5; ++n) { const bf16x8 bfm = *(const LAS bf16x8*)(WT + (g * 80 + n * 16 + fr) * RG_LD + ks * 32 + fq * 8);
                            acc[g][n] = __builtin_amdgcn_mfma_f32_16x16x32_bf16(af, bfm, acc[g][n], 0, 0, 0); }
                }
#pragma unroll
                for (int n = 0; n < 5; ++n) {
                    const int ch = n * 16 + fr; const float c8 = PRM[7 * 80 + ch];
                    float A = 1.f, H = 0.f;
#pragma unroll
                    for (int rg = 0; rg < 4; ++rg) {
                        const float v = __uint_as_float(((u32)VB[(t0 + fq * 4 + rg) * RG_LD + ch]) << 16);
                        const float r = __builtin_amdgcn_rcpf(1.f + __builtin_amdgcn_exp2f(acc[0][n][rg])), ig = __builtin_amdgcn_rcpf(1.f + __builtin_amdgcn_exp2f(acc[1][n][rg]));
                        const float a = __builtin_amdgcn_exp2f(-r * c8);
                        const float bt = __builtin_amdgcn_sqrtf(fmaf(-a, a, 1.f)) * (ig * v);
                        H = fmaf(a, H, bt); A *= a; hl[n][rg] = H; ca[n][rg] = A;
                    }
                    float Ap = __shfl_up(A, 16), Hp = __shfl_up(H, 16); if (fq >= 1) { H = fmaf(A, Hp, H); A = Ap * A; }
                    Ap = __shfl_up(A, 32); Hp = __shfl_up(H, 32); if (fq >= 2) { H = fmaf(A, Hp, H); A = Ap * A; }
                    float Ae = __shfl_up(A, 16), He = __shfl_up(H, 16); if (fq == 0) { Ae = 1.f; He = 0.f; }
                    Aw[n] = __shfl(A, 48 + fr); Hw[n] = __shfl(H, 48 + fr);
#pragma unroll
                    for (int rg = 0; rg < 4; ++rg) { hl[n][rg] = fmaf(ca[n][rg], He, hl[n][rg]); ca[n][rg] *= Ae; }
                }
            }
            if (fq == 0) {
#pragma unroll
                for (int n = 0; n < 5; ++n) { COMP[(wave * 80 + n * 16 + fr) * 2 + 0] = Aw[n]; COMP[(wave * 80 + n * 16 + fr) * 2 + 1] = Hw[n]; }
            }
            __syncthreads();
            float hin[5];
#pragma unroll
            for (int n = 0; n < 5; ++n) hin[n] = HST[(tt & 1) * 80 + n * 16 + fr];
#pragma unroll 1
            for (int w = 0; w < wave; ++w) {
#pragma unroll
                for (int n = 0; n < 5; ++n) { const int ch = n * 16 + fr; hin[n] = fmaf(COMP[(w * 80 + ch) * 2 + 0], hin[n], COMP[(w * 80 + ch) * 2 + 1]); }
            }
            if (wave == 7 && fq == 0) {
#pragma unroll
                for (int n = 0; n < 5; ++n) HST[((tt + 1) & 1) * 80 + n * 16 + fr] = fmaf(Aw[n], hin[n], Hw[n]);
            }
#pragma unroll
            for (int rg = 0; rg < 4; ++rg)
#pragma unroll
                for (int n = 0; n < 5; ++n) YB[(t0 + fq * 4 + rg) * RG_YLD + n * 16 + fr] = fmaf(ca[n][rg], hin[n], hl[n][rg]);
            if (more) RG_CONV(VBn);
            __syncthreads();
#pragma unroll
            for (int i = 0; i < 3; ++i) { if (i < 2 || has2) {
                const f32x4 y0 = *(const LAS f32x4*)(YB + pt[i] * RG_YLD + pc[i] * 8), y1 = *(const LAS f32x4*)(YB + pt[i] * RG_YLD + pc[i] * 8 + 4); const u32x4 sg = sgc[i];
                u32x4 w; w.x = pk2(y0[0] * bf_lo(sg.x), y0[1] * bf_hi(sg.x)); w.y = pk2(y0[2] * bf_lo(sg.y), y0[3] * bf_hi(sg.y)); w.z = pk2(y1[0] * bf_lo(sg.z), y1[1] * bf_hi(sg.z)); w.w = pk2(y1[2] * bf_lo(sg.w), y1[3] * bf_hi(sg.w));
                *(u32x4*)(a2b + (size_t)(tt * RG_TT + pt[i]) * K2 + pc[i] * 8) = w; } }
#pragma unroll
            for (int i = 0; i < 3; ++i) sgc[i] = sgn[i];
        }
#undef RG_LOAD
#undef RG_CONV
        __syncthreads();
    }
}

__device__ __forceinline__ void phase_final(const P& p) {
    const int tid = threadIdx.x, lane = tid & 63, wave = tid >> 6, G = gridDim.x;
    const float* rss = (const float*)(p.ws + WS_RSS);
    f32x4 gf[4];
#pragma unroll
    for (int j = 0; j < 4; ++j) gf[j] = *(const f32x4*)(p.g_final + 4 * lane + 256 * j);
    for (int r0 = (blockIdx.x * NWAVES + wave) * 16; r0 < M; r0 += G * NWAVES * 16) {
        for (int i = 0; i < 16; ++i) { const size_t r = (size_t)(r0 + i);
            float s = 0.f;
#pragma unroll
            for (int q = 0; q < 16; ++q) s += rss[(size_t)q * M + r];
            const float rstd = 1.0f / sqrtf(s * (1.0f / D) + EPS);
#pragma unroll
            for (int j = 0; j < 4; ++j) { float* o = p.out + r * D + 4 * lane + 256 * j; const f32x4 v = *(const f32x4*)o; *(f32x4*)o = v * rstd * gf[j]; }
        }
    }
}

__global__ void __launch_bounds__(NTHR, 2) fwd_kernel(P p) {
    extern __shared__ __attribute__((aligned(16))) unsigned char lds_raw[];
    LAS unsigned char* lds = (LAS unsigned char*)lds_raw;
    cg::grid_group grid = cg::this_grid();
    const int G = gridDim.x;
    bf16_t* Win_t = (bf16_t*)(p.ws + WS_WIN); bf16_t* W2_t = (bf16_t*)(p.ws + WS_W2); bf16_t* Wout_t = (bf16_t*)(p.ws + WS_WOUT);
    bf16_t* HN = (bf16_t*)(p.ws + WS_HN); bf16_t* MRG = HN; bf16_t* CV = (bf16_t*)(p.ws + WS_CV); bf16_t* RV = (bf16_t*)(p.ws + WS_RV); bf16_t* A2 = (bf16_t*)(p.ws + WS_A2);
    bf16_t* GR = (bf16_t*)(p.ws + WS_GR); bf16_t* GB = (bf16_t*)(p.ws + WS_GB);
#ifndef PHMASK
#define PHMASK 127
#endif
#define IN(k) (((PHMASK >> (k)) & 1) && p.ph_lo <= (k) && (k) < p.ph_hi)
#ifdef TIMING_K
    unsigned long long tstamp[8]; int nst = 0;
#define STAMP() do { tstamp[nst++] = __builtin_amdgcn_s_memrealtime(); } while (0)
#else
#define STAMP() do { } while (0)
#endif
    volatile LAS unsigned* xst = (volatile LAS unsigned*)(lds + LDS_BYTES - 16);
    if (threadIdx.x == 0) { xst[0] = 0u; xst[1] = 0u; }
    __syncthreads();
    const XcdBarrier xbar = xcd_barrier_post((unsigned*)(p.ws + WS_BAR), xst);
#define SEAM(k) do { if (IN(k) && IN((k) + 1)) { if ((k) == 0) grid.sync(); else xcd_barrier(xbar); } STAMP(); } while (0)
#ifndef REPMASK
#define REPMASK 0
#endif
#define NREP(k) (((REPMASK >> (k)) & 1) ? 2 : 1)
    STAMP();
    if (IN(0)) for (int rep = 0; rep < NREP(0); ++rep) phase_prep(p, lds);
    SEAM(0);
    if (IN(1)) for (int rep = 0; rep < NREP(1); ++rep) phase_h(p);
    SEAM(1);
    if (IN(2)) for (int rep = 0; rep < NREP(2); ++rep) { pg8::Gemm g{HN, Win_t, M, PIN, D, D, D}; pg8::StaticOrder S; S.init(M, PIN, G, (int)blockIdx.x);
        EpiIn E{CV, A2, RV, GR, GB, p.b_merge};
        pg8::gemm_phase<EpiIn, pg8::StaticOrder, true, true>(lds, g, S, E); }
    SEAM(2);
    if (IN(3)) {
#ifndef NO_CG
        phase_convgate(p);
#endif
#ifndef NO_RG
        phase_rglru(p, lds);
#endif
    }
    SEAM(3);
    if (IN(4)) for (int rep = 0; rep < NREP(4); ++rep) { pg8::StaticOrder S; S.init(M, D, G, (int)blockIdx.x);
        { pg8::Gemm g{A2, W2_t, M, D, D, K2, K2}; EpiMerge<false> E{GR, MRG}; pg8::gemm_phase<EpiMerge<false>, pg8::StaticOrder, true, true>(lds, g, S, E); }
        { pg8::Gemm g{A2 + D, W2_t + D, M, D, RGW, K2, K2}; EpiMerge<true> E{GB, MRG}; pg8::gemm_phase<EpiMerge<true>, pg8::StaticOrder, true, true>(lds, g, S, E); } }
    SEAM(4);
    if (IN(5)) for (int rep = 0; rep < NREP(5); ++rep) { pg8::Gemm g{MRG, Wout_t, M, D, D, D, D}; pg8::StaticOrder S; S.init(M, D, G, (int)blockIdx.x);
        EpiOut E{p.x, (const float*)(p.ws + WS_MOD), p.out, (float*)(p.ws + WS_RSS)};
        pg8::gemm_phase<EpiOut, pg8::StaticOrder, true, true>(lds, g, S, E); }
    SEAM(5);
    if (IN(6)) phase_final(p);
#ifdef TIMING_K
    STAMP();
    if (blockIdx.x == 0 && threadIdx.x == 0) {
        p.out[0] += (float)(tstamp[TIMING_K + 1] - tstamp[TIMING_K]) * 0.01f;
        if (TIMING_K + 2 < 8) p.out[1] += (float)(tstamp[TIMING_K + 2] - tstamp[TIMING_K + 1]) * 0.01f; }
#endif
#undef IN
#undef SEAM
}

extern "C" void kernel_launch(void* const* d_in, const int* in_sizes, int n_in, void* d_out, int out_size, void* d_ws, size_t ws_size, hipStream_t stream) {
    static int grid = 0;
    if (grid == 0) {
        if (n_in != 20 || out_size != M * D || ws_size < WS_END) { fprintf(stderr, "kernel_launch: unexpected shapes (n_in %d, out %d, ws %zu)\n", n_in, out_size, ws_size); grid = -1; return; }
        int dev = 0, cus = 0, per_cu = 0;
        (void)hipGetDevice(&dev); (void)hipDeviceGetAttribute(&cus, hipDeviceAttributeMultiprocessorCount, dev);
        if (hipFuncSetAttribute((const void*)fwd_kernel, hipFuncAttributeMaxDynamicSharedMemorySize, LDS_BYTES) != hipSuccess) { fprintf(stderr, "kernel_launch: hipFuncSetAttribute failed\n"); grid = -1; return; }
        if (hipOccupancyMaxActiveBlocksPerMultiprocessor(&per_cu, (const void*)fwd_kernel, NTHR, LDS_BYTES) != hipSuccess || per_cu < 1) { fprintf(stderr, "kernel_launch: occupancy query says %d blocks per CU\n", per_cu); per_cu = 1; }
        (void)hipGetLastError();
        if (cus <= 0) cus = 256;
        grid = cus * 1;
    }
    if (grid < 0) return;
    if (hipMemsetAsync((char*)d_ws + WS_BAR, 0, XCD_BAR_WORDS * sizeof(unsigned), stream) != hipSuccess) { fprintf(stderr, "kernel_launch: memset of the barrier words failed\n"); return; }
    P p{};
    const float** dst = (const float**)&p;
    for (int i = 0; i < 20; ++i) dst[i] = (const float*)d_in[i];
    p.out = (float*)d_out; p.ws = (unsigned char*)d_ws;
#if N_LAUNCHES == 1
    p.ph_lo = 0; p.ph_hi = 7;
    void* args[] = {&p};
    hipError_t e = hipLaunchCooperativeKernel((const void*)fwd_kernel, dim3(grid), dim3(NTHR), args, LDS_BYTES, stream);
    if (e != hipSuccess) fprintf(stderr, "kernel_launch: cooperative launch failed: %s (grid %d)\n", hipGetErrorString(e), grid);
#else
    for (int k = 0; k < 7; ++k) { p.ph_lo = k; p.ph_hi = k + 1; hipLaunchKernelGGL(fwd_kernel, dim3(grid), dim3(NTHR), LDS_BYTES, stream, p); }
#endif
}
```
